# Optimizing an MI355X kernel written in HIP

```python
import jax, jax.numpy as jnp
from jax import lax
import numpy as np

D_MODEL = 1024
BATCH = 8
SEQ = 8192
DEPTH = 2

N_A_LAYERS = DEPTH // 2
N_B_LAYERS = DEPTH - N_A_LAYERS
RET_HEADS = 4
RET_QK_DIM = D_MODEL // RET_HEADS
RET_V_DIM = 2 * RET_QK_DIM
RET_QK_WIDTH = RET_HEADS * RET_QK_DIM
RET_V_WIDTH = RET_HEADS * RET_V_DIM
RET_IN_WIDTH = 2 * RET_QK_WIDTH + 2 * RET_V_WIDTH
RET_CHUNK = 128
ROPE_BASE = 10000.0
SB_HEADS = 16
SB_HEAD_DIM = D_MODEL // SB_HEADS
SB_BLOCK = 128
D_FF = -(-(8 * D_MODEL) // (3 * 256)) * 256
RMS_EPS = 1e-6
GN_EPS = 1e-5

kernel_name = "yoco_retention_stickbreaking_trunk"


def rmsnorm(x, g):
    xf = x.astype(jnp.float32)
    y = xf * lax.rsqrt(jnp.mean(xf * xf, axis=-1, keepdims=True) + RMS_EPS)
    return (y * g.astype(jnp.float32)).astype(x.dtype)


def rotary(t, pos):
    half = t.shape[-1] // 2
    inv_freq = ROPE_BASE ** (-jnp.arange(half, dtype=jnp.float32) / half)
    ang = pos[:, None] * inv_freq[None, :]
    cos, sin = jnp.cos(ang), jnp.sin(ang)
    t1, t2 = t[..., :half], t[..., half:]
    return jnp.concatenate([t1 * cos - t2 * sin, t1 * sin + t2 * cos], axis=-1)


def retention(h, w_in, gn_g, w_out):
    B, S, _ = h.shape
    H, dk, dv, C = RET_HEADS, RET_QK_DIM, RET_V_DIM, RET_CHUNK
    n = S // C
    proj = h @ w_in
    q, k, v, g = jnp.split(proj, [RET_QK_WIDTH, 2 * RET_QK_WIDTH, 2 * RET_QK_WIDTH + RET_V_WIDTH], axis=-1)
    q = q.reshape(B, S, H, dk).transpose(0, 2, 1, 3).astype(jnp.float32)
    k = k.reshape(B, S, H, dk).transpose(0, 2, 1, 3).astype(jnp.float32)
    v = v.reshape(B, S, H, dv).transpose(0, 2, 1, 3).astype(jnp.float32)
    pos = jnp.arange(S, dtype=jnp.float32)
    q = rotary(q, pos)
    k = rotary(k, pos) * (dk ** -0.5)

    log_g = jnp.log(1.0 - 2.0 ** (-5.0 - jnp.arange(H, dtype=jnp.float32)))
    j = jnp.arange(C, dtype=jnp.float32)
    rel = j[:, None] - j[None, :]
    inner_decay = jnp.where(rel[None] >= 0, jnp.exp(rel[None] * log_g[:, None, None]), 0.0)
    q_decay = jnp.exp((j[None, :] + 1.0) * log_g[:, None])
    k_decay = jnp.exp((C - 1.0 - j[None, :]) * log_g[:, None])
    chunk_decay = jnp.exp(C * log_g)

    def to_chunks(t):
        return t.reshape(B, H, n, C, t.shape[-1]).transpose(2, 0, 1, 3, 4)

    def step(state, qkv):
        qc, kc, vc = qkv
        scores = jnp.einsum('bhid,bhjd->bhij', qc, kc) * inner_decay[None]
        inner = jnp.einsum('bhij,bhjv->bhiv', scores, vc)
        cross = jnp.einsum('bhid,bhdv->bhiv', qc, state) * q_decay[None, :, :, None]
        state = state * chunk_decay[None, :, None, None] + jnp.einsum(
            'bhjd,bhjv->bhdv', kc * k_decay[None, :, :, None], vc)
        return state, inner + cross

    state0 = jnp.zeros((B, H, dk, dv), jnp.float32)
    _, o = lax.scan(step, state0, (to_chunks(q), to_chunks(k), to_chunks(v)))
    o = o.transpose(1, 2, 0, 3, 4).reshape(B, H, S, dv)
    mu = jnp.mean(o, axis=-1, keepdims=True)
    oc = o - mu
    o = oc * lax.rsqrt(jnp.mean(oc * oc, axis=-1, keepdims=True) + GN_EPS)
    o = o.transpose(0, 2, 1, 3).reshape(B, S, RET_V_WIDTH) * gn_g.astype(jnp.float32)
    y = (jax.nn.silu(g.astype(jnp.float32)) * o).astype(h.dtype)
    return y @ w_out


def shared_kv(x, kv_norm_g, w_kv):
    B, S, _ = x.shape
    kv = rmsnorm(x, kv_norm_g) @ w_kv
    k, v = jnp.split(kv, 2, axis=-1)
    k = k.reshape(B, S, SB_HEADS, SB_HEAD_DIM).transpose(0, 2, 1, 3)
    v = v.reshape(B, S, SB_HEADS, SB_HEAD_DIM).transpose(0, 2, 1, 3)
    return k, v


def stick_breaking(h, w_q, k, v, w_out):
    B, S, _ = h.shape
    H, dh, Bk = SB_HEADS, SB_HEAD_DIM, SB_BLOCK
    nb = S // Bk
    q = (h @ w_q).reshape(B, S, H, dh).transpose(0, 2, 1, 3) * (dh ** -0.5)
    q_blocks = q.reshape(B, H, nb, Bk, dh).transpose(2, 0, 1, 3, 4)
    idx = jnp.arange(Bk)
    diag_mask = idx[None, :] < idx[:, None]

    def one_query_block(args):
        qi, blk = args
        qi = qi.astype(jnp.float32)

        def body(step, carry):
            acc, logsurv = carry
            kb = blk - step
            kblk = lax.dynamic_slice_in_dim(k, kb * Bk, Bk, axis=2).astype(jnp.float32)
            vblk = lax.dynamic_slice_in_dim(v, kb * Bk, Bk, axis=2).astype(jnp.float32)
            z = jnp.einsum('bhid,bhjd->bhij', qi, kblk)
            valid = jnp.logical_or(diag_mask, step > 0)[None, None]
            neg_log_1m_beta = jnp.where(valid, jax.nn.softplus(z), 0.0)
            suffix = lax.cumsum(neg_log_1m_beta, axis=3, reverse=True) - neg_log_1m_beta
            log_a = -jax.nn.softplus(-z) - suffix - logsurv[..., None]
            a = jnp.where(valid, jnp.exp(log_a), 0.0)
            acc = acc + jnp.einsum('bhij,bhjd->bhid', a, vblk)
            logsurv = logsurv + jnp.sum(neg_log_1m_beta, axis=-1)
            return acc, logsurv

        init = (jnp.zeros((B, H, Bk, dh), jnp.float32), jnp.zeros((B, H, Bk), jnp.float32))
        acc, _ = lax.fori_loop(0, blk + 1, body, init)
        return acc

    o = lax.map(one_query_block, (q_blocks, jnp.arange(nb)))
    o = o.transpose(1, 0, 3, 2, 4).reshape(B, S, H * dh).astype(h.dtype)
    return o @ w_out


def swiglu(h, w_in, w_out):
    gate, up = jnp.split(h @ w_in, 2, axis=-1)
    return (jax.nn.silu(gate) * up) @ w_out


def setup_inputs(seed: int = 0) -> dict:
    key = jax.random.key(seed)
    ks = jax.random.split(key, 16)
    f32 = jnp.float32
    out_scale = (2.0 * DEPTH) ** -0.5

    def nrm(k, shape, fan_in, scale=1.0):
        return jax.random.normal(k, shape, f32) * (fan_in ** -0.5) * scale

    def gain(k, shape):
        return 1.0 + 0.02 * jax.random.normal(k, shape, f32)

    return {
        "x": jax.random.normal(ks[0], (BATCH, SEQ, D_MODEL), f32),
        "mix_norm_g": gain(ks[1], (DEPTH, D_MODEL)),
        "w_ret_in": nrm(ks[2], (N_A_LAYERS, D_MODEL, RET_IN_WIDTH), D_MODEL),
        "ret_gn_g": gain(ks[3], (N_A_LAYERS, RET_V_WIDTH)),
        "w_ret_out": nrm(ks[4], (N_A_LAYERS, RET_V_WIDTH, D_MODEL), RET_V_WIDTH, out_scale),
        "kv_norm_g": gain(ks[5], (D_MODEL,)),
        "w_kv": nrm(ks[6], (D_MODEL, 2 * D_MODEL), D_MODEL),
        "w_sb_q": nrm(ks[7], (N_B_LAYERS, D_MODEL, SB_HEADS * SB_HEAD_DIM), D_MODEL),
        "w_sb_out": nrm(ks[8], (N_B_LAYERS, SB_HEADS * SB_HEAD_DIM, D_MODEL), SB_HEADS * SB_HEAD_DIM, out_scale),
        "ffn_norm_g": gain(ks[9], (DEPTH, D_MODEL)),
        "w_ffn_in": nrm(ks[10], (DEPTH, D_MODEL, 2 * D_FF), D_MODEL),
        "w_ffn_out": nrm(ks[11], (DEPTH, D_FF, D_MODEL), D_FF, out_scale),
        "final_norm_g": gain(ks[12], (D_MODEL,)),
    }


def reference(x, mix_norm_g, w_ret_in, ret_gn_g, w_ret_out, kv_norm_g, w_kv,
              w_sb_q, w_sb_out, ffn_norm_g, w_ffn_in, w_ffn_out, final_norm_g):
    k_shared = None
    v_shared = None
    for layer in range(DEPTH):
        if layer < N_A_LAYERS:
            i = layer
            x = x + retention(rmsnorm(x, mix_norm_g[layer]), w_ret_in[i], ret_gn_g[i], w_ret_out[i])
        else:
            if layer == N_A_LAYERS:
                k_shared, v_shared = shared_kv(x, kv_norm_g, w_kv)
            i = layer - N_A_LAYERS
            x = x + stick_breaking(rmsnorm(x, mix_norm_g[layer]), w_sb_q[i], k_shared, v_shared, w_sb_out[i])
        x = x + swiglu(rmsnorm(x, ffn_norm_g[layer]), w_ffn_in[layer], w_ffn_out[layer])
    return rmsnorm(x, final_norm_g)
```

```cpp
#include <hip/hip_runtime.h>
#include <hip/hip_cooperative_groups.h>
#include <cstdio>
#include <cstdint>
namespace cg = cooperative_groups;
typedef float f32x2v __attribute__((ext_vector_type(2)));
namespace pg8 {
#define PG8_LAS __attribute__((address_space(3)))
typedef unsigned short bf16_t;
typedef short bf16x8 __attribute__((ext_vector_type(8)));
typedef float f32x4 __attribute__((ext_vector_type(4)));
typedef unsigned u32x4 __attribute__((ext_vector_type(4)));
constexpr int BM = 256, BK = 64, HALF = 128, HTB = HALF * BK * 2  , STAGE_BYTES = 8 * HTB, NXCD = 8, WGM = 8;

__host__ __device__ __forceinline__ int lds_byte(int r, int c) { const int st = (r >> 4) * 2 + (c >> 5), rr = r & 15, cc = c & 31, ob = rr * 64 + cc * 2; return st * 1024 + (ob ^ (((ob >> 9) & 1) << 5)); }
__host__ __device__ __forceinline__ void stage_rc(int b, int& R, int& C) { const int st = b / 1024, sb = b % 1024, swz = sb ^ (((sb >> 9) & 1) << 5); R = (st >> 1) * 16 + swz / 64; C = (st & 1) * 32 + (swz % 64) / 2; }
__host__ __device__ __forceinline__ int perm32(int rho) { const int n = rho >> 4, i = rho & 15; return 8 * (i >> 2) + 4 * n + (i & 3); }

struct Unit { int pm, pn; };
struct Gemm { const bf16_t* A; const bf16_t* Bt; int M, N, K; };

struct StaticOrder {
    int nM, nN, nwg, G, c;
    __host__ __device__ void init(int M, int N, int G_, int c_) { nM = M / BM; nN = N / BM; nwg = nM * nN; G = G_; c = c_; }
    __host__ __device__ bool next(int i, Unit& u) const {
        const long L = (long)i * G + c; if (L >= nwg) return false;
        int wgid = (int)L; { const int q = nwg / NXCD, r = nwg % NXCD, xcd = wgid % NXCD, off = wgid / NXCD; wgid = (xcd < r ? xcd * (q + 1) : r * (q + 1) + (xcd - r) * q) + off; }
        const int nig = WGM * nN, gid = wgid / nig, fm = gid * WGM, gsz = (nM - fm) < WGM ? (nM - fm) : WGM;
        u.pm = fm + ((wgid % nig) % gsz); u.pn = (wgid % nig) / gsz; return true;
    }
    __device__ __forceinline__ void a_ready(const Unit&) const {}
    __device__ __forceinline__ void done(const Unit&) const {}
};
typedef __bf16 bf16x2n __attribute__((ext_vector_type(2)));
typedef float f32x2n __attribute__((ext_vector_type(2)));
__device__ __forceinline__ unsigned cvt_pk_bf16(float lo, float hi) { const f32x2n v = {lo, hi}; return __builtin_bit_cast(unsigned, __builtin_convertvector(v, bf16x2n)); }
typedef float f32x2 __attribute__((ext_vector_type(2)));
__device__ __forceinline__ float row_rinv1(const float* ssq, int row, int fq) {
    const f32x4 p = *(const f32x4*)(ssq + (size_t)row * 16 + 4 * fq);
    float s = (p[0] + p[1]) + (p[2] + p[3]);
    s += __shfl_xor(s, 16); s += __shfl_xor(s, 32);
    return __builtin_amdgcn_rsqf(s * (1.0f / 1024.0f) + 1e-6f);
}
__device__ __forceinline__ u32x4 pack8(const f32x4 a, const f32x4 b) { u32x4 w; w.x = cvt_pk_bf16(a[0], a[1]); w.y = cvt_pk_bf16(a[2], a[3]); w.z = cvt_pk_bf16(b[0], b[1]); w.w = cvt_pk_bf16(b[2], b[3]); return w; }

struct EpiProj {
    static constexpr bool PERM = true, AFTER_DRAIN = false;
    bf16_t *q, *v; const float* ssq;
    __device__ __forceinline__ void operator()(const f32x4 (&acc)[2][2][4][2], const Unit& u, int wr, int wc, int fr, int fq) const {
        const int pn = u.pn;
        if (pn < 8) {
            bf16_t* base = q + (size_t)(pn >> 2) * ((size_t)64 << 20) + (pn & 3) * 256 + wc * 32 + 8 * fq; const float sc = pn < 4 ? 1.0f : 0.0625f;
            const float lgs = __builtin_amdgcn_logf(1.0f - __builtin_amdgcn_exp2f(-5.0f - (float)(pn & 3))) * (pn < 4 ? 1.0f : -1.0f);
            float invf[2][4];
#pragma unroll
            for (int n = 0; n < 2; ++n)
#pragma unroll
                for (int e = 0; e < 4; ++e) invf[n][e] = __builtin_amdgcn_exp2f(-(float)(32 * wc + 8 * fq + 4 * n + e) * (13.287712379549449f / 128.0f)) * 0.15915494309189535f;
#pragma unroll
            for (int ai = 0; ai < 2; ++ai)
#pragma unroll
                for (int m = 0; m < 4; ++m) {
                    const int row = u.pm * BM + ai * HALF + wr * 64 + m * 16 + fr; const float pos = (float)(row & 8191), r = sc * __builtin_amdgcn_exp2f((float)(row & 127) * lgs);
                    f32x4 o1[2], o2[2];
#pragma unroll
                    for (int n = 0; n < 2; ++n) { const f32x4 t1 = acc[ai][0][m][n] * r, t2 = acc[ai][1][m][n] * r;
#pragma unroll
                        for (int e = 0; e < 4; ++e) { const float fx = __builtin_amdgcn_fractf(pos * invf[n][e]); const float s = __builtin_amdgcn_sinf(fx), c = __builtin_amdgcn_cosf(fx);
                            o1[n][e] = t1[e] * c - t2[e] * s; o2[n][e] = t1[e] * s + t2[e] * c; } }
                    if (pn < 4) {
                        const int s_ = row & 8191, d0 = wc * 32 + 8 * fq; const size_t it4 = ((size_t)(((row >> 13) * 4 + pn) * 64 + (s_ >> 7)) * 4 + ((s_ >> 5) & 3)) * 16;
                        bf16_t* f0 = q + ((it4 + (d0 >> 4)) * 64 + (fq & 1) * 32 + (s_ & 31)) * 8;
                        *(u32x4*)f0 = pack8(o1[0], o1[1]); *(u32x4*)(f0 + 8 * 64 * 8) = pack8(o2[0], o2[1]);
                    } else { bf16_t* rowp = base + (size_t)row * 1024; *(u32x4*)(rowp) = pack8(o1[0], o1[1]); *(u32x4*)(rowp + 128) = pack8(o2[0], o2[1]); }
                }
        } else {
            bf16_t* base = v + (size_t)((pn - 8) >> 3) * ((size_t)128 << 20) + (pn & 7) * 256 + wc * 32 + 8 * fq;
#pragma unroll
            for (int ai = 0; ai < 2; ++ai)
#pragma unroll
                for (int m = 0; m < 4; ++m) {
                    const int row = u.pm * BM + ai * HALF + wr * 64 + m * 16 + fr; bf16_t* rowp = base + (size_t)row * 2048;
#pragma unroll
                    for (int bj = 0; bj < 2; ++bj) *(u32x4*)(rowp + bj * HALF) = pack8(acc[ai][bj][m][0], acc[ai][bj][m][1]);
                }
        }
    }
};
struct EpiSwiGLU {
    static constexpr bool PERM = true, AFTER_DRAIN = false;
    bf16_t* H; const float* ssq;
    __device__ __forceinline__ void operator()(const f32x4 (&acc)[2][2][4][2], const Unit& u, int wr, int wc, int fr, int fq) const {
        bf16_t* base = H + u.pn * 128 + wc * 32 + 8 * fq;
#pragma unroll
        for (int ai = 0; ai < 2; ++ai)
#pragma unroll
            for (int m = 0; m < 4; ++m) {
                const int row = u.pm * BM + ai * HALF + wr * 64 + m * 16 + fr;
                f32x4 hv[2];
#pragma unroll
                for (int n = 0; n < 2; ++n) { const f32x4 gt = acc[ai][0][m][n], up = acc[ai][1][m][n];
#pragma unroll
                    for (int e = 0; e < 4; ++e) hv[n][e] = gt[e] * __builtin_amdgcn_rcpf(1.0f + __builtin_amdgcn_exp2f(-1.4426950408889634f * gt[e])) * up[e]; }
                *(u32x4*)(base + (size_t)row * 2816) = pack8(hv[0], hv[1]);
            }
    }
};
struct EpiKVQ {
    static constexpr bool PERM = true, AFTER_DRAIN = false;
    bf16_t *K; const float* ssq; float qscale;
    __device__ __forceinline__ void operator()(const f32x4 (&acc)[2][2][4][2], const Unit& u, int wr, int wc, int fr, int fq) const {
        const int pn = u.pn; const float sc = pn < 8 ? 1.0f : qscale;
        bf16_t* base = K + (size_t)(pn >> 2) * ((size_t)64 << 20) + (pn & 3) * 256 + wc * 32 + 8 * fq;
#pragma unroll
        for (int ai = 0; ai < 2; ++ai)
#pragma unroll
            for (int m = 0; m < 4; ++m) {
                const int row = u.pm * BM + ai * HALF + wr * 64 + m * 16 + fr; const float r = sc; bf16_t* rowp = base + (size_t)row * 1024;
#pragma unroll
                for (int bj = 0; bj < 2; ++bj) *(u32x4*)(rowp + bj * HALF) = pack8(acc[ai][bj][m][0] * r, acc[ai][bj][m][1] * r);
            }
    }
};
struct EpiResid {
    static constexpr bool PERM = true, AFTER_DRAIN = false;
    const float* base; float* out; bf16_t* xb; float* ssq;
    __device__ __forceinline__ void operator()(const f32x4 (&acc)[2][2][4][2], const Unit& u, int wr, int wc, int fr, int fq) const {
#pragma unroll
        for (int ai = 0; ai < 2; ++ai)
#pragma unroll
            for (int m = 0; m < 4; ++m) {
                const int row = u.pm * BM + ai * HALF + wr * 64 + m * 16 + fr; const size_t off = (size_t)row * 1024 + u.pn * BM + wc * 32 + 8 * fq; float ss = 0.f;
#pragma unroll
                for (int bj = 0; bj < 2; ++bj) {
                    const f32x4 x0 = *(const f32x4*)(base + off + bj * HALF) + acc[ai][bj][m][0], x1 = *(const f32x4*)(base + off + bj * HALF + 4) + acc[ai][bj][m][1];
                    *(f32x4*)(out + off + bj * HALF) = x0; *(f32x4*)(out + off + bj * HALF + 4) = x1;
                    ss += (x0[0] * x0[0] + x0[1] * x0[1]) + (x0[2] * x0[2] + x0[3] * x0[3]) + (x1[0] * x1[0] + x1[1] * x1[1]) + (x1[2] * x1[2] + x1[3] * x1[3]);
                    *(u32x4*)(xb + off + bj * HALF) = pack8(x0, x1);
                }
                ss += __shfl_xor(ss, 16); ss += __shfl_xor(ss, 32);
                if (fq == 0) ssq[(size_t)row * 16 + 4 * u.pn + wc] = ss;
            }
    }
};

template <bool FINAL> struct EpiNorm {
    static constexpr bool PERM = true, AFTER_DRAIN = false;
    const float* base; float* out; bf16_t* xb; const float* g; float* xsum; unsigned* cnt; unsigned want; PG8_LAS float* P; PG8_LAS float* S;
    __device__ __forceinline__ void operator()(f32x4 (&acc)[2][2][4][2], const Unit& u, int wr, int wc, int fr, int fq) const {
        const int tid = threadIdx.x, lane = tid & 63, wid = __builtin_amdgcn_readfirstlane(tid >> 6);
#pragma unroll
        for (int ai = 0; ai < 2; ++ai)
#pragma unroll
            for (int m = 0; m < 4; ++m) {
                const int rl = ai * HALF + wr * 64 + m * 16 + fr; const size_t off = (size_t)(u.pm * BM + rl) * 1024 + u.pn * BM + wc * 32 + 8 * fq; float ss = 0.f;
#pragma unroll
                for (int bj = 0; bj < 2; ++bj) {
                    const f32x4 x0 = *(const f32x4*)(base + off + bj * HALF) + acc[ai][bj][m][0], x1 = *(const f32x4*)(base + off + bj * HALF + 4) + acc[ai][bj][m][1];
                    acc[ai][bj][m][0] = x0; acc[ai][bj][m][1] = x1;
                    if (!FINAL) { *(f32x4*)(out + off + bj * HALF) = x0; *(f32x4*)(out + off + bj * HALF + 4) = x1; }
                    ss += (x0[0] * x0[0] + x0[1] * x0[1]) + (x0[2] * x0[2] + x0[3] * x0[3]) + (x1[0] * x1[0] + x1[1] * x1[1]) + (x1[2] * x1[2] + x1[3] * x1[3]);
                }
                ss += __shfl_xor(ss, 16); ss += __shfl_xor(ss, 32);
                if (fq == 0) P[rl * 4 + wc] = ss;
            }
        asm volatile("s_waitcnt lgkmcnt(0)" ::: "memory"); __builtin_amdgcn_s_barrier(); asm volatile("" ::: "memory");
        if (tid < 256) {
            const float s = (P[tid * 4 + 0] + P[tid * 4 + 1]) + (P[tid * 4 + 2] + P[tid * 4 + 3]);
            __hip_atomic_store(xsum + (size_t)(u.pm * BM + tid) * 4 + u.pn, s, __ATOMIC_RELAXED, __HIP_MEMORY_SCOPE_AGENT);
            asm volatile("s_waitcnt vmcnt(0)" ::: "memory");
            if (lane == 0) __hip_atomic_fetch_add(cnt + 64 * u.pm, 1u, __ATOMIC_RELAXED, __HIP_MEMORY_SCOPE_AGENT);
        }
        if (wid == 0) {
            unsigned spins = 0;
            while ((unsigned)__builtin_amdgcn_readfirstlane(__hip_atomic_load(cnt + 64 * u.pm, __ATOMIC_RELAXED, __HIP_MEMORY_SCOPE_AGENT)) < want) { __builtin_amdgcn_s_sleep(2); if (++spins > (1u << 24)) break; }
            __builtin_amdgcn_fence(__ATOMIC_ACQUIRE, "agent");
        }
        asm volatile("s_waitcnt vmcnt(0) lgkmcnt(0)" ::: "memory"); __builtin_amdgcn_s_barrier(); asm volatile("" ::: "memory");
        if (tid < 256) {
            const float* sl = xsum + (size_t)(u.pm * BM + tid) * 4;
            const float t = (__hip_atomic_load(sl, __ATOMIC_RELAXED, __HIP_MEMORY_SCOPE_AGENT) + __hip_atomic_load(sl + 1, __ATOMIC_RELAXED, __HIP_MEMORY_SCOPE_AGENT)) +
                            (__hip_atomic_load(sl + 2, __ATOMIC_RELAXED, __HIP_MEMORY_SCOPE_AGENT) + __hip_atomic_load(sl + 3, __ATOMIC_RELAXED, __HIP_MEMORY_SCOPE_AGENT));
            S[tid] = 1.0f / sqrtf(t * (1.0f / 1024.0f) + 1e-6f);
        }
        asm volatile("s_waitcnt vmcnt(0) lgkmcnt(0)" ::: "memory"); __builtin_amdgcn_s_barrier(); asm volatile("" ::: "memory");
        f32x4 gv[2][2];
        if (FINAL) {
#pragma unroll
            for (int bj = 0; bj < 2; ++bj) { gv[bj][0] = *(const f32x4*)(g + u.pn * BM + bj * HALF + wc * 32 + 8 * fq); gv[bj][1] = *(const f32x4*)(g + u.pn * BM + bj * HALF + wc * 32 + 8 * fq + 4); } }
#pragma unroll
        for (int ai = 0; ai < 2; ++ai)
#pragma unroll
            for (int m = 0; m < 4; ++m) {
                const int rl = ai * HALF + wr * 64 + m * 16 + fr; const size_t off = (size_t)(u.pm * BM + rl) * 1024 + u.pn * BM + wc * 32 + 8 * fq; const float r = S[rl];
#pragma unroll
                for (int bj = 0; bj < 2; ++bj) {
                    if (FINAL) { *(f32x4*)(out + off + bj * HALF) = acc[ai][bj][m][0] * r * gv[bj][0]; *(f32x4*)(out + off + bj * HALF + 4) = acc[ai][bj][m][1] * r * gv[bj][1]; }
                    else *(u32x4*)(xb + off + bj * HALF) = pack8(acc[ai][bj][m][0] * r, acc[ai][bj][m][1] * r);
                }
            }
        asm volatile("s_waitcnt lgkmcnt(0)" ::: "memory"); __builtin_amdgcn_s_barrier(); asm volatile("" ::: "memory");
    }
};
template <class Epi, class Sched, bool ALIGN_EPI = false, bool SP2 = false>
__device__ __forceinline__ void gemm_phase(PG8_LAS unsigned char* lds, const Gemm g, const Sched& S, const Epi& E) {
    const int tid = threadIdx.x, wid = __builtin_amdgcn_readfirstlane(tid >> 6), lane = tid & 63, wr = wid >> 2, wc = wid & 3, fr = lane & 15, fq = lane >> 4;
    const int K = g.K, nt = K / BK;
    unsigned voffA[2], voffB[2];
#pragma unroll
    for (int i = 0; i < 2; ++i) { int R, C; stage_rc(tid * 16 + i * 8192, R, C); const int Rb = Epi::PERM ? ((R & ~31) + perm32(R & 31)) : R;
        voffA[i] = (unsigned)(R * K + C) * 2u; voffB[i] = (unsigned)(Rb * K + C) * 2u; }
    const size_t kstep = (size_t)(BK * 2);
    const size_t hstep = (size_t)HALF * K * 2;
    const size_t tstep = 2 * hstep;
    const unsigned ldsw = (unsigned)wid * 1024u;
    const int aoff = lds_byte(wr * 64 + fr, fq * 8), boff = lds_byte(wc * 32 + fr, fq * 8);
#define PG8_SA(b, h) (((b) * 2 + (h)) * HTB)
#define PG8_SB(b, h) ((4 + (b) * 2 + (h)) * HTB)
#define PG8_STAGE(bufoff, gbase, voff) do { _Pragma("unroll") for (int _i = 0; _i < 2; ++_i) \
        __builtin_amdgcn_global_load_lds((const unsigned*)((const char*)(gbase) + (voff)[_i]), (PG8_LAS unsigned*)(lds + (bufoff) + ldsw + _i * 8192), 16, 0, 0); } while (0)
#define PG8_LDA(dst, b, h) do { _Pragma("unroll") for (int m = 0; m < 4; ++m) _Pragma("unroll") for (int k = 0; k < 2; ++k) dst[m][k] = *(const PG8_LAS bf16x8*)(lds + PG8_SA(b, h) + aoff + m * 2048 + k * 1024); } while (0)
#define PG8_LDB(dst, b, h) do { _Pragma("unroll") for (int n = 0; n < 2; ++n) _Pragma("unroll") for (int k = 0; k < 2; ++k) dst[n][k] = *(const PG8_LAS bf16x8*)(lds + PG8_SB(b, h) + boff + n * 2048 + k * 1024); } while (0)
#define PG8_MMA(ai, bj, At, Bt) do { __builtin_amdgcn_s_setprio(1); _Pragma("unroll") for (int m = 0; m < 4; ++m) _Pragma("unroll") for (int n = 0; n < 2; ++n) _Pragma("unroll") for (int k = 0; k < 2; ++k) \
        acc[ai][bj][m][n] = __builtin_amdgcn_mfma_f32_16x16x32_bf16(Bt[n][k], At[m][k], acc[ai][bj][m][n], 0, 0, 0); __builtin_amdgcn_s_setprio(0); } while (0)
#define PG8_WAIT_V(n) asm volatile("s_waitcnt vmcnt(" #n ")" ::: "memory")
#define PG8_WAIT_L(n) asm volatile("s_waitcnt lgkmcnt(" #n ")" ::: "memory")
#define PG8_BAR __builtin_amdgcn_s_barrier()
#define PG8_SCHED __builtin_amdgcn_sched_barrier(0)
    Unit cur, nxt; int ui = 0;
    if (!S.next(0, cur)) return;
    f32x4 acc[2][2][4][2];
#pragma unroll
    for (int a = 0; a < 2; ++a)
#pragma unroll
        for (int b = 0; b < 2; ++b)
#pragma unroll
            for (int m = 0; m < 4; ++m)
#pragma unroll
                for (int n = 0; n < 2; ++n) acc[a][b][m][n] = (f32x4){0.f, 0.f, 0.f, 0.f};
    bf16x8 At[4][2], B0[2][2], B1[2][2];
    const char* cA = (const char*)g.A + (size_t)cur.pm * tstep; const char* cB = (const char*)g.Bt + (size_t)cur.pn * tstep;
    S.a_ready(cur);
    if constexpr (SP2) {
        PG8_STAGE(PG8_SB(0, 0), cB, voffB); PG8_STAGE(PG8_SB(0, 1), cB + hstep, voffB); PG8_STAGE(PG8_SA(0, 0), cA, voffA); PG8_STAGE(PG8_SA(0, 1), cA + hstep, voffA);
        if (wr == 1) PG8_BAR;
        PG8_WAIT_V(2); PG8_BAR;
        PG8_STAGE(PG8_SB(1, 0), cB + kstep, voffB); PG8_STAGE(PG8_SA(1, 0), cA + kstep, voffA); PG8_STAGE(PG8_SB(1, 1), cB + hstep + kstep, voffB);
        PG8_WAIT_V(6); PG8_BAR;
    } else {
        PG8_STAGE(PG8_SB(0, 0), cB, voffB); PG8_STAGE(PG8_SA(0, 0), cA, voffA); PG8_STAGE(PG8_SB(0, 1), cB + hstep, voffB); PG8_STAGE(PG8_SA(0, 1), cA + hstep, voffA);
        if (wr == 1) PG8_BAR;
        PG8_WAIT_V(4); PG8_BAR;
        PG8_STAGE(PG8_SB(1, 0), cB + kstep, voffB); PG8_STAGE(PG8_SA(1, 0), cA + kstep, voffA); PG8_STAGE(PG8_SB(1, 1), cB + hstep + kstep, voffB);
        PG8_WAIT_V(6); PG8_BAR;
    }
    for (;;) {
        const bool has_next = S.next(ui + 1, nxt);
        const char* nA = has_next ? (const char*)g.A + (size_t)nxt.pm * tstep : cA; const char* nB = has_next ? (const char*)g.Bt + (size_t)nxt.pn * tstep : cB;
        for (int t = 0; t < nt; t += 2) {
            const bool last = (t == nt - 2);
            const char* a1 = cA + (size_t)(t + 1) * kstep;
            const char* a2 = last ? nA : cA + (size_t)(t + 2) * kstep; const char* b2 = last ? nB : cB + (size_t)(t + 2) * kstep;
            const char* a3 = a2 + kstep; const char* b3 = b2 + kstep;
            if (last && has_next) S.a_ready(nxt);
            if constexpr (SP2) {
            PG8_LDB(B0, 0, 0); PG8_LDB(B1, 0, 1); PG8_SCHED; PG8_LDA(At, 0, 0); PG8_STAGE(PG8_SA(1, 1), a1 + hstep, voffA);
            PG8_WAIT_V(8); PG8_WAIT_L(0); PG8_BAR; PG8_MMA(0, 0, At, B0); PG8_MMA(0, 1, At, B1); PG8_BAR; PG8_SCHED;
            PG8_LDA(At, 0, 1); PG8_STAGE(PG8_SB(0, 0), b2, voffB); PG8_STAGE(PG8_SB(0, 1), b2 + hstep, voffB); PG8_STAGE(PG8_SA(0, 0), a2, voffA);
            PG8_WAIT_V(8); PG8_WAIT_L(0); PG8_BAR; PG8_MMA(1, 0, At, B0); PG8_MMA(1, 1, At, B1); PG8_BAR; PG8_SCHED;
            PG8_LDB(B0, 1, 0); PG8_LDB(B1, 1, 1); PG8_SCHED; PG8_LDA(At, 1, 0); PG8_STAGE(PG8_SA(0, 1), a2 + hstep, voffA);
            PG8_WAIT_V(8); PG8_WAIT_L(0); PG8_BAR; PG8_MMA(0, 0, At, B0); PG8_MMA(0, 1, At, B1); PG8_BAR; PG8_SCHED;
            PG8_LDA(At, 1, 1); PG8_STAGE(PG8_SB(1, 0), b3, voffB); PG8_STAGE(PG8_SB(1, 1), b3 + hstep, voffB); PG8_STAGE(PG8_SA(1, 0), a3, voffA);
            PG8_WAIT_V(8); PG8_WAIT_L(0); PG8_BAR; PG8_MMA(1, 0, At, B0); PG8_MMA(1, 1, At, B1); PG8_BAR; PG8_SCHED;
            } else {
            PG8_LDB(B0, 0, 0); PG8_SCHED; PG8_LDA(At, 0, 0); PG8_STAGE(PG8_SA(1, 1), a1 + hstep, voffA);
            PG8_WAIT_L(8); PG8_BAR; PG8_WAIT_L(0); PG8_MMA(0, 0, At, B0); PG8_BAR; PG8_SCHED;
            PG8_LDB(B1, 0, 1); PG8_STAGE(PG8_SB(0, 0), b2, voffB);
            PG8_BAR; PG8_WAIT_L(0); PG8_MMA(0, 1, At, B1); PG8_BAR;
            PG8_LDA(At, 0, 1); PG8_STAGE(PG8_SA(0, 0), a2, voffA);
            PG8_BAR; PG8_WAIT_L(0); PG8_MMA(1, 0, At, B0); PG8_BAR; PG8_SCHED;
            PG8_STAGE(PG8_SB(0, 1), b2 + hstep, voffB);
            PG8_WAIT_V(6); PG8_BAR; PG8_MMA(1, 1, At, B1); PG8_BAR;
            PG8_LDB(B0, 1, 0); PG8_SCHED; PG8_LDA(At, 1, 0); PG8_STAGE(PG8_SA(0, 1), a2 + hstep, voffA);
            PG8_WAIT_L(8); PG8_BAR; PG8_WAIT_L(0); PG8_MMA(0, 0, At, B0); PG8_BAR; PG8_SCHED;
            PG8_LDB(B1, 1, 1); PG8_STAGE(PG8_SB(1, 0), b3, voffB);
            PG8_BAR; PG8_WAIT_L(0); PG8_MMA(0, 1, At, B1); PG8_BAR;
            PG8_LDA(At, 1, 1); PG8_STAGE(PG8_SA(1, 0), a3, voffA);
            PG8_BAR; PG8_WAIT_L(0); PG8_MMA(1, 0, At, B0); PG8_BAR; PG8_SCHED;
            PG8_STAGE(PG8_SB(1, 1), b3 + hstep, voffB);
            PG8_WAIT_V(6); PG8_BAR; PG8_MMA(1, 1, At, B1); PG8_BAR;
            }
        }
        if constexpr (ALIGN_EPI) { if (wr == 0) PG8_BAR; }
        if constexpr (!Epi::AFTER_DRAIN) { E(acc, cur, wr, wc, fr, fq); S.done(cur); }
        if (!has_next) break;
#pragma unroll
        for (int a = 0; a < 2; ++a)
#pragma unroll
            for (int b = 0; b < 2; ++b)
#pragma unroll
                for (int m = 0; m < 4; ++m)
#pragma unroll
                    for (int n = 0; n < 2; ++n) acc[a][b][m][n] = (f32x4){0.f, 0.f, 0.f, 0.f};
        cur = nxt; cA = nA; cB = nB; ++ui;
        if constexpr (ALIGN_EPI) { if (wr == 1) PG8_BAR; }
    }
    PG8_WAIT_V(0);
    if constexpr (!ALIGN_EPI) { if (wr == 0) PG8_BAR; }
    PG8_BAR;
    if constexpr (Epi::AFTER_DRAIN) { E.fused(acc, cur, wr, wc, fr, fq, lds, wid, lane); S.done(cur); }
#undef PG8_SA
#undef PG8_SB
#undef PG8_STAGE
#undef PG8_LDA
#undef PG8_LDB
#undef PG8_MMA
#undef PG8_WAIT_V
#undef PG8_WAIT_L
#undef PG8_BAR
#undef PG8_SCHED
}
}
#define LAS __attribute__((address_space(3)))
typedef unsigned short bf16;
typedef short bf16x8 __attribute__((ext_vector_type(8)));
typedef short s16x4 __attribute__((ext_vector_type(4)));
typedef float f32x4 __attribute__((ext_vector_type(4)));
typedef float f32x16 __attribute__((ext_vector_type(16)));
typedef unsigned u32x4 __attribute__((ext_vector_type(4)));
typedef unsigned u32x2 __attribute__((ext_vector_type(2)));
#define MFMA32(a, b, c) __builtin_amdgcn_mfma_f32_32x32x16_bf16((a), (b), (c), 0, 0, 0)
__device__ __forceinline__ s16x4 vtr(const LAS unsigned char* p) { return __builtin_bit_cast(s16x4, __builtin_amdgcn_ds_read_tr16_b64_v4i16((LAS s16x4*)p)); }
__device__ __forceinline__ bf16x8 cat8(s16x4 lo, s16x4 hi) { return __builtin_shufflevector(lo, hi, 0, 1, 2, 3, 4, 5, 6, 7); }
__device__ __forceinline__ unsigned pkbf(float lo, float hi) { return pg8::cvt_pk_bf16(lo, hi); }
__device__ __forceinline__ float ex2(float x) { return __builtin_amdgcn_exp2f(x); }
__device__ __forceinline__ float lg2(float x) { return __builtin_amdgcn_logf(x); }

#define XB_TMO      128
#define XB_XCNT(j)  (256  + 64 * (j))
#define XB_XSUB(j)  (1280 + 64 * (j))
#define XB_XGEN(j)  (2304 + 64 * (j))
#define XB_TOP      3328
#define XB_TOPGEN   3392
#define XCD_BAR_WORDS 3456
#define XB_SPIN_CAP (1u << 18)

__device__ __forceinline__ unsigned xb_ld(unsigned* p)              { return __hip_atomic_load(p, __ATOMIC_RELAXED, __HIP_MEMORY_SCOPE_AGENT); }
__device__ __forceinline__ unsigned xb_add(unsigned* p, unsigned v) { return __hip_atomic_fetch_add(p, v, __ATOMIC_RELAXED, __HIP_MEMORY_SCOPE_AGENT); }
__device__ __forceinline__ unsigned xb_xcc_id() { return (unsigned)__builtin_amdgcn_s_getreg((3 << 11) | 20) & 0xFu; }
#define XB_SPIN(cond, bar) do { unsigned _sp = 0; while (cond) { __builtin_amdgcn_s_sleep(1); \
    if ((++_sp & 255u) == 0u) { if (xb_ld(&(bar)[XB_TMO])) break; if (_sp > XB_SPIN_CAP) { atomicAdd(&(bar)[XB_TMO], 1u); break; } } } } while (0)

struct XcdBarrier {
    unsigned* bar; unsigned x;
    volatile LAS unsigned* st;
};

__device__ __forceinline__ XcdBarrier xcd_barrier_post(unsigned* bar, volatile LAS unsigned* st) {
    XcdBarrier b; b.bar = bar; b.x = xb_xcc_id(); b.st = st;
    if (threadIdx.x == 0) (void)xb_add(&bar[XB_XCNT(b.x)], 1u);
    return b;
}
__device__ __forceinline__ void xcd_barrier_complete(unsigned* bar, unsigned x, unsigned& nloc, unsigned& nx) {
    const unsigned G = gridDim.x * gridDim.y * gridDim.z;
    unsigned sum, cnt, mine, sp = 0u;
    for (;;) {
        sum = 0u; cnt = 0u; mine = 0u;
#pragma unroll
        for (unsigned j = 0; j < 16; ++j) { const unsigned c = xb_ld(&bar[XB_XCNT(j)]); sum += c; cnt += (c > 0u) ? 1u : 0u; mine = (j == x) ? c : mine; }
        if (sum == G) break;
        __builtin_amdgcn_s_sleep(1);
        if ((++sp & 255u) == 0u) { if (xb_ld(&bar[XB_TMO])) break; if (sp > XB_SPIN_CAP) { atomicAdd(&bar[XB_TMO], 1u); break; } }
    }
    nloc = mine > 0u ? mine : 1u; nx = cnt > 0u ? cnt : 1u;
}

__device__ __forceinline__ void xcd_barrier(const XcdBarrier& b) {
    asm volatile("s_waitcnt vmcnt(0)" ::: "memory");
    __syncthreads();
    if (threadIdx.x == 0) {
        unsigned* bar = b.bar;
        __builtin_amdgcn_s_waitcnt(0);
        unsigned nloc = b.st[0], nx = b.st[1];
        if (nloc == 0u) { xcd_barrier_complete(bar, b.x, nloc, nx); b.st[0] = nloc; b.st[1] = nx; }
        const unsigned old = xb_add(&bar[XB_XSUB(b.x)], 1u);
        const unsigned gen = old / nloc;
        if (old + 1u == (gen + 1u) * nloc) {
            __builtin_amdgcn_fence(__ATOMIC_RELEASE, "agent");
            asm volatile("s_waitcnt vmcnt(0)" ::: "memory");
            const unsigned og = xb_add(&bar[XB_TOP], 1u);
            const unsigned tg = og / nx;
            if (og + 1u == (tg + 1u) * nx) xb_add(&bar[XB_TOPGEN], 1u);
            else XB_SPIN(xb_ld(&bar[XB_TOPGEN]) == tg, bar);
            __builtin_amdgcn_fence(__ATOMIC_ACQUIRE, "agent");
            xb_add(&bar[XB_XGEN(b.x)], 1u);
            asm volatile("s_waitcnt vmcnt(0)" ::: "memory");
        } else {
            XB_SPIN(xb_ld(&bar[XB_XGEN(b.x)]) == gen, bar);
            __builtin_amdgcn_fence(__ATOMIC_ACQUIRE, "agent");
            asm volatile("s_waitcnt vmcnt(0)" ::: "memory");
        }
    }
    __syncthreads();
}


constexpr int BATCH = 8, SEQ = 8192, DM = 1024, MTOK = BATCH * SEQ, DFF = 2816;
constexpr int NWAVES = 8, NTHR = 512, LDS_BYTES = 147456, LDS_BARW = 147440;
constexpr size_t MiB = 1u << 20;
constexpr size_t WS_WRI = 0, WS_WRO = 12 * MiB, WS_WKVQ = 16 * MiB, WS_WSO = 22 * MiB, WS_WFI0 = 24 * MiB, WS_WFI1 = 35 * MiB, WS_WFO0 = 46 * MiB, WS_WFO1 = 46 * MiB + 5632 * 1024, WS_SSQ = 57 * MiB;
constexpr size_t WS_BAR = 61 * MiB, BAR_BYTES = 131072;
constexpr size_t WS_XB = 64 * MiB, WS_STATS = 192 * MiB, WS_BIG = 224 * MiB;
constexpr size_t WS_RQ = WS_BIG, WS_RK = WS_BIG + 128 * MiB, WS_RV = WS_BIG + 256 * MiB, WS_RG = WS_BIG + 512 * MiB, WS_RY = WS_BIG;
constexpr size_t WS_HID = WS_BIG;
constexpr size_t WS_SO = WS_BIG, WS_SK = WS_BIG + 352 * MiB, WS_SV = WS_BIG + 480 * MiB, WS_SQ = WS_BIG + 608 * MiB, WS_END = WS_BIG + 768 * MiB;

__device__ __forceinline__ int opaque_tid() { int t = threadIdx.x; asm volatile("" : "+v"(t)); return t; }
__device__ __forceinline__ float wave_sum(float v) {
#pragma unroll
    for (int o = 1; o < 64; o <<= 1) v += __shfl_xor(v, o);
    return v;
}
__device__ __forceinline__ void transpose_item(const float* W, int K, int N, bf16* WT, const float* gain, int k0, int n0, int orow0, LAS float* scr, int lane) {
#pragma unroll 4
    for (int i = 0; i < 16; ++i) { const int kk = 4 * i + (lane >> 4); f32x4 w = *(const f32x4*)(W + (size_t)(k0 + kk) * N + n0 + 4 * (lane & 15)); if (gain) w = w * gain[k0 + kk];
        LAS float* d = scr + kk * 65 + 4 * (lane & 15); d[0] = w[0]; d[1] = w[1]; d[2] = w[2]; d[3] = w[3]; }
    asm volatile("s_waitcnt lgkmcnt(0)" ::: "memory");
#pragma unroll
    for (int j = 0; j < 8; ++j) { const int p = lane + 64 * j, n = p >> 3, c = p & 7; const LAS float* q = scr + (8 * c) * 65 + n;
        u32x4 o; o.x = pkbf(q[0 * 65], q[1 * 65]); o.y = pkbf(q[2 * 65], q[3 * 65]); o.z = pkbf(q[4 * 65], q[5 * 65]); o.w = pkbf(q[6 * 65], q[7 * 65]);
        *(u32x4*)(WT + (size_t)(orow0 + n) * K + k0 + 8 * c) = o; }
    asm volatile("s_waitcnt lgkmcnt(0)" ::: "memory");
}
__device__ __forceinline__ bool tr_matrix(int& r, const float* W, int K, int N, bf16* WT, const float* gain, int row_off, bool ffn, LAS float* scr, int lane) {
    const int nblk = N / 64, items = (K / 64) * nblk;
    if (r >= items) { r -= items; return false; }
    const int kb = r / nblk, nb = r % nblk, n0 = 64 * nb; int orow0 = row_off + n0;
    if (ffn) { const int j = n0 < DFF ? n0 : n0 - DFF; orow0 = 256 * (j >> 7) + (j & 127) + (n0 < DFF ? 0 : 128); }
    transpose_item(W, K, N, WT, gain, 64 * kb, n0, orow0, scr, lane);
    return true;
}
struct Args { const float* in[13]; float* out; unsigned char* ws; int ph_lo, ph_hi; };

__device__ __forceinline__ void prologue(const Args& a, LAS unsigned char* lds, int G, int bid) {
    const int tid = opaque_tid(), lane = tid & 63, wave = __builtin_amdgcn_readfirstlane(tid >> 6), gw = bid * NWAVES + wave, NGW = G * NWAVES;
    LAS float* scr = (LAS float*)(lds + wave * 16640);
    unsigned char* ws = a.ws;
    constexpr int NITEMS = 1536 + 512 + 512 + 256 + 256 + 2 * 1408 + 2 * 704;
    for (int it = gw; it < NITEMS; it += NGW) {
        int r = it;
        if (tr_matrix(r, a.in[2], 1024, 6144, (bf16*)(ws + WS_WRI), a.in[1], 0, false, scr, lane)) continue;
        if (tr_matrix(r, a.in[4], 2048, 1024, (bf16*)(ws + WS_WRO), nullptr, 0, false, scr, lane)) continue;
        if (tr_matrix(r, a.in[6], 1024, 2048, (bf16*)(ws + WS_WKVQ), a.in[5], 0, false, scr, lane)) continue;
        if (tr_matrix(r, a.in[7], 1024, 1024, (bf16*)(ws + WS_WKVQ), a.in[1] + 1024, 2048, false, scr, lane)) continue;
        if (tr_matrix(r, a.in[8], 1024, 1024, (bf16*)(ws + WS_WSO), nullptr, 0, false, scr, lane)) continue;
        if (tr_matrix(r, a.in[10], 1024, 5632, (bf16*)(ws + WS_WFI0), a.in[9], 0, true, scr, lane)) continue;
        if (tr_matrix(r, a.in[10] + (size_t)1024 * 5632, 1024, 5632, (bf16*)(ws + WS_WFI1), a.in[9] + 1024, 0, true, scr, lane)) continue;
        if (tr_matrix(r, a.in[11], 2816, 1024, (bf16*)(ws + WS_WFO0), nullptr, 0, false, scr, lane)) continue;
        tr_matrix(r, a.in[11] + (size_t)2816 * 1024, 2816, 1024, (bf16*)(ws + WS_WFO1), nullptr, 0, false, scr, lane);
    }
    const float* x = a.in[0]; bf16* xb = (bf16*)(ws + WS_XB);
    for (int m = gw; m < MTOK; m += NGW) {
        const f32x4* xr = (const f32x4*)(x + (size_t)m * DM) + lane; u32x2* o8 = (u32x2*)(xb + (size_t)m * DM) + lane; float s = 0.f; f32x4 v[4];
#pragma unroll
        for (int j = 0; j < 4; ++j) { v[j] = xr[64 * j]; s += (v[j][0] * v[j][0] + v[j][1] * v[j][1]) + (v[j][2] * v[j][2] + v[j][3] * v[j][3]); }
        const float r = 1.0f / sqrtf(wave_sum(s) * (1.0f / 1024.0f) + 1e-6f);
#pragma unroll
        for (int j = 0; j < 4; ++j) { u32x2 o; o.x = pkbf(v[j][0] * r, v[j][1] * r); o.y = pkbf(v[j][2] * r, v[j][3] * r); o8[64 * j] = o; }
    }
}

__device__ __forceinline__ void ret_scores_phase(LAS unsigned char* lds, const bf16* RQ, const bf16* RK, unsigned char* PB, int G, int bid) {
    const int tid = opaque_tid(), lane = tid & 63, w = __builtin_amdgcn_readfirstlane(tid >> 6), r32 = lane & 31, hh = lane >> 5;
    LAS unsigned char* KS = lds;
    const unsigned goff = (unsigned)(tid >> 5) * 2048u + (unsigned)(tid & 31) * 16u, loff = (unsigned)(tid >> 5) * 528u + (unsigned)(tid & 31) * 16u, roff = (unsigned)r32 * 528u + 16u * hh;
    u32x4 kpre[8];
    int it = bid;
    if (it < 2048) { const int bh_ = it >> 6, c = it & 63; const size_t go = (((size_t)(bh_ >> 2) * SEQ + c * 128) * 1024 + (bh_ & 3) * 256) * 2;
#pragma unroll
        for (int i = 0; i < 8; ++i) kpre[i] = *(const u32x4*)((const char*)RK + go + (size_t)(16 * i) * 2048 + goff); }
    for (; it < 2048; it += G) {
        __syncthreads();
#pragma unroll
        for (int i = 0; i < 8; ++i) *(LAS u32x4*)(KS + loff + i * (16 * 528)) = kpre[i];
        __syncthreads();
        if (it + G < 2048) { const int i2 = it + G, bh_ = i2 >> 6, c = i2 & 63; const size_t go = (((size_t)(bh_ >> 2) * SEQ + c * 128) * 1024 + (bh_ & 3) * 256) * 2;
#pragma unroll
            for (int i = 0; i < 8; ++i) kpre[i] = *(const u32x4*)((const char*)RK + go + (size_t)(16 * i) * 2048 + goff); }
        for (int tix = w; tix < 10; tix += 8) {
            const int qi = tix < 1 ? 0 : (tix < 3 ? 1 : (tix < 6 ? 2 : 3)), kj = tix - (qi * (qi + 1)) / 2;
            const char* qa = (const char*)RQ + ((size_t)(it * 4 + qi) * 16) * 1024 + lane * 16; const LAS unsigned char* ka = KS + kj * (32 * 528) + roff;
            bf16x8 qb[16];
#pragma unroll
            for (int t = 0; t < 16; ++t) qb[t] = *(const bf16x8*)(qa + t * 1024);
            f32x16 s0, s1;
#pragma unroll
            for (int i = 0; i < 16; ++i) { s0[i] = 0.f; s1[i] = 0.f; }
#pragma unroll
            for (int t = 0; t < 16; t += 2) {
                const bf16x8 a0 = *(const LAS bf16x8*)(ka + 32 * t), a1 = *(const LAS bf16x8*)(ka + 32 * t + 32);
                s0 = MFMA32(a0, qb[t], s0); s1 = MFMA32(a1, qb[t + 1], s1); }
#pragma unroll
            for (int i = 0; i < 16; ++i) { float p = s0[i] + s1[i]; if (kj == qi && (8 * (i >> 2) + 4 * hh + (i & 3)) > r32) p = 0.f; s0[i] = p; }
            u32x4 p0, p1;
#pragma unroll
            for (int e = 0; e < 4; ++e) { p0[e] = pkbf(s0[2 * e], s0[2 * e + 1]); p1[e] = pkbf(s0[8 + 2 * e], s0[8 + 2 * e + 1]); }
            unsigned char* pt = PB + ((size_t)it * 10 + tix) * 2048 + lane * 16;
            *(u32x4*)pt = p0; *(u32x4*)(pt + 1024) = p1;
        }
    }
    __syncthreads();
}
constexpr int R_KL = 0, R_VL = 128 * 576, R_SL = R_VL + 128 * 192;
template <bool owave> __device__ __forceinline__ void retention_role(LAS unsigned char* lds, const bf16* RQ, const bf16* RK, bf16* RV, const unsigned char* PB, float* stats, int G, int bid, int tid) {
    const int lane = tid & 63, w = __builtin_amdgcn_readfirstlane(tid >> 6), r32 = lane & 31, hh = lane >> 5, q4 = (lane & 15) >> 2, p4 = lane & 3, gsel = (lane >> 4) & 1;
    LAS unsigned char* KL = lds + R_KL; LAS unsigned char* VL = lds + R_VL; LAS unsigned char* SL = lds + R_SL;
    const int qi = w & 3, sw = w & 3, tbase = (qi * (qi + 1)) / 2;
    const LAS unsigned char* pv_base = VL + (4 * hh + q4) * 192 + (16 * gsel + 4 * p4) * 2;
    const LAS unsigned char* ktr_base = KL + (8 * hh + q4) * 576 + (64 * sw + 16 * gsel + 4 * p4) * 2;
    const LAS unsigned char* vtr_base = VL + (8 * hh + q4) * 192 + (16 * gsel + 4 * p4) * 2;
    const unsigned koff = (unsigned)(tid >> 5) * 2048u + (unsigned)(tid & 31) * 16u, voff = (unsigned)(tid >> 3) * 4096u + (unsigned)(tid & 7) * 16u;
    const unsigned qoff = (unsigned)(32 * qi + r32) * 2048u + 16u * hh, ooff = (unsigned)(32 * qi + r32) * 4096u + (unsigned)(4 * hh) * 2u, soff = (unsigned)(32 * qi + r32) * 512u;
    const unsigned poff = (unsigned)tbase * 2048u + (unsigned)lane * 16u;
    for (int it = bid; it < 256; it += G) {
        const int bh_ = (it & 7) * 4 + (it >> 6), vs = (it >> 3) & 7, b = bh_ >> 2, h = bh_ & 3;
        const float cdec = ex2(128.0f * log2f(1.0f - exp2f(-5.0f - (float)h)));
        const char* Qp = (const char*)RQ + ((size_t)(bh_ * 64) * 4 + qi) * 16 * 1024 + lane * 16;
        const char* Kp = (const char*)(RK + (size_t)b * SEQ * 1024 + h * 256);
        char* Vp = (char*)(RV + (size_t)b * SEQ * 2048 + h * 512 + vs * 64);
        const unsigned char* Pp = PB + (size_t)bh_ * 64 * 10 * 2048;
        char* stp = (char*)(stats + ((size_t)b * SEQ * 4 + h) * 32 + (vs * 2) * 2);
        f32x16 st[2][2];
#pragma unroll
        for (int i = 0; i < 16; ++i) { st[0][0][i] = 0.f; st[0][1][i] = 0.f; st[1][0][i] = 0.f; st[1][1][i] = 0.f; }
        u32x4 kpre[8], vpre[2], pp[4][2]; bf16x8 qf[16];
#pragma unroll
        for (int i = 0; i < 8; ++i) kpre[i] = *(const u32x4*)(Kp + (size_t)(16 * i) * 2048 + koff);
#pragma unroll
        for (int i = 0; i < 2; ++i) vpre[i] = *(const u32x4*)(Vp + (size_t)(64 * i) * 4096 + voff);
        if (owave) {
#pragma unroll
            for (int t = 0; t < 16; ++t) qf[t] = *(const bf16x8*)(Qp + t * 1024);
#pragma unroll
            for (int kj = 0; kj < 4; ++kj) if (kj <= qi) { pp[kj][0] = *(const u32x4*)(Pp + kj * 2048 + poff); pp[kj][1] = *(const u32x4*)(Pp + kj * 2048 + 1024 + poff); }
        }
        for (int c = 0; c < 64; ++c) {
            __syncthreads();
#pragma unroll
            for (int i = 0; i < 8; ++i) *(LAS u32x4*)(KL + (tid >> 5) * 576 + (tid & 31) * 16 + i * (16 * 576)) = kpre[i];
#pragma unroll
            for (int i = 0; i < 2; ++i) *(LAS u32x4*)(VL + (tid >> 3) * 192 + (tid & 7) * 16 + i * (64 * 192)) = vpre[i];
            if (!owave) {
#pragma unroll
                for (int dt = 0; dt < 2; ++dt)
#pragma unroll
                    for (int vt = 0; vt < 2; ++vt)
#pragma unroll
                        for (int k = 0; k < 4; ++k) { u32x2 a0; a0.x = pkbf(st[dt][vt][4 * k], st[dt][vt][4 * k + 1]); a0.y = pkbf(st[dt][vt][4 * k + 2], st[dt][vt][4 * k + 3]);
                            *(LAS u32x2*)(SL + (32 * vt + r32) * 528 + (64 * sw + 32 * dt + 4 * hh) * 2 + 16 * k) = a0; }
            }
            __syncthreads();
            if (c + 1 < 64) {
                const char* kc = Kp + (size_t)(c + 1) * (128 * 2048); const char* vc = Vp + (size_t)(c + 1) * (128 * 4096);
#pragma unroll
                for (int i = 0; i < 8; ++i) kpre[i] = *(const u32x4*)(kc + (size_t)(16 * i) * 2048 + koff);
#pragma unroll
                for (int i = 0; i < 2; ++i) vpre[i] = *(const u32x4*)(vc + (size_t)(64 * i) * 4096 + voff);
            }
            __builtin_amdgcn_sched_barrier(0);
            if (owave) {
                f32x16 o0, o1;
#pragma unroll
                for (int i = 0; i < 16; ++i) { o0[i] = 0.f; o1[i] = 0.f; }
                { const LAS unsigned char* sa = SL + r32 * 528 + 16 * hh;
                  bf16x8 ra[4], rb[4];
#pragma unroll
                  for (int t = 0; t < 4; ++t) { ra[t] = *(const LAS bf16x8*)(sa + 32 * t); rb[t] = *(const LAS bf16x8*)(sa + 32 * 528 + 32 * t); }
                  __builtin_amdgcn_sched_group_barrier(0x100, 8, 0);
#pragma unroll
                  for (int t = 0; t < 16; ++t) {
                      o0 = MFMA32(ra[t & 3], qf[t], o0); o1 = MFMA32(rb[t & 3], qf[t], o1);
                      __builtin_amdgcn_sched_group_barrier(0x8, 2, 0);
                      if (t + 4 < 16) { ra[t & 3] = *(const LAS bf16x8*)(sa + 32 * (t + 4)); rb[t & 3] = *(const LAS bf16x8*)(sa + 32 * 528 + 32 * (t + 4)); __builtin_amdgcn_sched_group_barrier(0x100, 2, 0); }
                  } }
#pragma unroll
                for (int i = 0; i < 16; ++i) { o0[i] *= cdec; o1[i] *= cdec; }
                if (c + 1 < 64) {
                    const char* qc = Qp + (size_t)(c + 1) * (4 * 16 * 1024);
#pragma unroll
                    for (int t = 0; t < 16; ++t) qf[t] = *(const bf16x8*)(qc + t * 1024);
                }
                __builtin_amdgcn_sched_barrier(0);
#pragma unroll
                for (int kj = 0; kj < 4; ++kj) if (kj <= qi) {
                    const LAS unsigned char* vb = pv_base + kj * (32 * 192);
                    const s16x4 v0 = vtr(vb), v1 = vtr(vb + 8 * 192), v2 = vtr(vb + 64), v3 = vtr(vb + 8 * 192 + 64), v4 = vtr(vb + 16 * 192), v5 = vtr(vb + 24 * 192), v6 = vtr(vb + 16 * 192 + 64), v7 = vtr(vb + 24 * 192 + 64);
                    __builtin_amdgcn_sched_group_barrier(0x100, 8, 2);
                    o0 = MFMA32(cat8(v0, v1), __builtin_bit_cast(bf16x8, pp[kj][0]), o0);
                    o1 = MFMA32(cat8(v2, v3), __builtin_bit_cast(bf16x8, pp[kj][0]), o1);
                    o0 = MFMA32(cat8(v4, v5), __builtin_bit_cast(bf16x8, pp[kj][1]), o0);
                    o1 = MFMA32(cat8(v6, v7), __builtin_bit_cast(bf16x8, pp[kj][1]), o1);
                    __builtin_amdgcn_sched_group_barrier(0x8, 4, 2);
                }
                if (c + 1 < 64) {
                    const unsigned char* pc = Pp + (size_t)(c + 1) * (10 * 2048);
#pragma unroll
                    for (int kj = 0; kj < 4; ++kj) if (kj <= qi) { pp[kj][0] = *(const u32x4*)(pc + kj * 2048 + poff); pp[kj][1] = *(const u32x4*)(pc + kj * 2048 + 1024 + poff); }
                }
                __builtin_amdgcn_sched_barrier(0);
                { char* oc = Vp + (size_t)c * (128 * 4096); float s1 = 0.f, s2 = 0.f, t1 = 0.f, t2 = 0.f;
#pragma unroll
                  for (int k = 0; k < 4; ++k) { u32x2 ov; ov.x = pkbf(o0[4 * k], o0[4 * k + 1]); ov.y = pkbf(o0[4 * k + 2], o0[4 * k + 3]); *(u32x2*)(oc + 16 * k + ooff) = ov;
                      u32x2 ow; ow.x = pkbf(o1[4 * k], o1[4 * k + 1]); ow.y = pkbf(o1[4 * k + 2], o1[4 * k + 3]); *(u32x2*)(oc + 64 + 16 * k + ooff) = ow;
#pragma unroll
                      for (int r = 0; r < 4; ++r) { s1 += o0[4 * k + r]; s2 += o0[4 * k + r] * o0[4 * k + r]; t1 += o1[4 * k + r]; t2 += o1[4 * k + r] * o1[4 * k + r]; } }
                  s1 += __shfl_xor(s1, 32); s2 += __shfl_xor(s2, 32); t1 += __shfl_xor(t1, 32); t2 += __shfl_xor(t2, 32);
                  if (hh == 0) { f32x4 sv; sv[0] = s1; sv[1] = s2; sv[2] = t1; sv[3] = t2; *(f32x4*)(stp + (size_t)c * (128 * 512) + soff) = sv; } }
            } else if (c + 1 < 64) {
#pragma unroll
                for (int i = 0; i < 16; ++i) { st[0][0][i] *= cdec; st[0][1][i] *= cdec; st[1][0][i] *= cdec; st[1][1][i] *= cdec; }
                {
                    s16x4 fa[2][4], fb[2][4];
#define ST_LOAD(buf, t) do { fa[buf][0] = vtr(ktr_base + (16 * (t)) * 576); fa[buf][1] = vtr(ktr_base + (16 * (t) + 4) * 576); fa[buf][2] = vtr(ktr_base + (16 * (t)) * 576 + 64); fa[buf][3] = vtr(ktr_base + (16 * (t) + 4) * 576 + 64); \
                             fb[buf][0] = vtr(vtr_base + (16 * (t)) * 192); fb[buf][1] = vtr(vtr_base + (16 * (t) + 4) * 192); fb[buf][2] = vtr(vtr_base + (16 * (t)) * 192 + 64); fb[buf][3] = vtr(vtr_base + (16 * (t) + 4) * 192 + 64); } while (0)
                    ST_LOAD(0, 0); __builtin_amdgcn_sched_group_barrier(0x100, 8, 1);
#pragma unroll
                    for (int t = 0; t < 8; ++t) {
                        if (t + 1 < 8) { ST_LOAD((t + 1) & 1, t + 1); __builtin_amdgcn_sched_group_barrier(0x100, 8, 1); }
                        const bf16x8 a0 = cat8(fa[t & 1][0], fa[t & 1][1]), a1 = cat8(fa[t & 1][2], fa[t & 1][3]), b0 = cat8(fb[t & 1][0], fb[t & 1][1]), b1 = cat8(fb[t & 1][2], fb[t & 1][3]);
                        st[0][0] = MFMA32(a0, b0, st[0][0]); st[0][1] = MFMA32(a0, b1, st[0][1]); st[1][0] = MFMA32(a1, b0, st[1][0]); st[1][1] = MFMA32(a1, b1, st[1][1]);
                        __builtin_amdgcn_sched_group_barrier(0x8, 4, 1);
                    }
#undef ST_LOAD
                }
            }
        }
        __syncthreads();
    }
}

__device__ __forceinline__ void retention_phase(LAS unsigned char* lds, const bf16* RQ, const bf16* RK, bf16* RV, const unsigned char* PB, float* stats, unsigned* dbg, int G, int bid) {
    const int tid = opaque_tid();
    if (__builtin_amdgcn_readfirstlane(tid >> 6) < 4) retention_role<true>(lds, RQ, RK, RV, PB, stats, G, bid, tid);
    else retention_role<false>(lds, RQ, RK, RV, PB, stats, G, bid, tid);
}

__device__ __forceinline__ void gngate_phase(const bf16* RV, const bf16* RG, bf16* RY, const float* stats, const float* gng, int G, int bid) {
    const int tid = opaque_tid(), lane = tid & 63, gw = bid * NWAVES + __builtin_amdgcn_readfirstlane(tid >> 6), NGW = G * NWAVES;
    for (int idx = gw; idx < MTOK * 4; idx += NGW) {
        const int h = idx & 3; const size_t off = (size_t)(idx >> 2) * 2048 + h * 512 + 8 * lane;
        const u32x4 ov = *(const u32x4*)(RV + off), gv = *(const u32x4*)(RG + off);
        const f32x4 g0 = *(const f32x4*)(gng + h * 512 + 8 * lane), g1 = *(const f32x4*)(gng + h * 512 + 8 * lane + 4);
        f32x2v sv = {0.f, 0.f}; if (lane < 16) sv = *(const f32x2v*)(stats + ((size_t)idx * 16 + lane) * 2);
        float s1 = sv.x, s2 = sv.y;
#pragma unroll
        for (int o = 1; o < 16; o <<= 1) { s1 += __shfl_xor(s1, o); s2 += __shfl_xor(s2, o); }
        s1 = __shfl(s1, 0); s2 = __shfl(s2, 0);
        const float mu = s1 * (1.0f / 512.0f), var = fmaxf(s2 * (1.0f / 512.0f) - mu * mu, 0.f), rstd = __builtin_amdgcn_rsqf(var + 1e-5f);
        float y[8];
#pragma unroll
        for (int e = 0; e < 4; ++e) {
            const float oa = __uint_as_float(ov[e] << 16), ob = __uint_as_float(ov[e] & 0xffff0000u), ga = __uint_as_float(gv[e] << 16), gb = __uint_as_float(gv[e] & 0xffff0000u);
            const float wa = e < 2 ? g0[2 * e] : g1[2 * e - 4], wb = e < 2 ? g0[2 * e + 1] : g1[2 * e - 3];
            y[2 * e] = ga * __builtin_amdgcn_rcpf(1.0f + ex2(-1.4426950408889634f * ga)) * ((oa - mu) * rstd * wa);
            y[2 * e + 1] = gb * __builtin_amdgcn_rcpf(1.0f + ex2(-1.4426950408889634f * gb)) * ((ob - mu) * rstd * wb);
        }
        u32x4 yo; yo.x = pkbf(y[0], y[1]); yo.y = pkbf(y[2], y[3]); yo.z = pkbf(y[4], y[5]); yo.w = pkbf(y[6], y[7]);
        *(u32x4*)(RY + off) = yo;
    }
}

template <int MODE> __device__ __forceinline__ void sb_tile(f32x16& z, float& carry, int r32, int hh) {
    if (MODE == 2) {
#pragma unroll
        for (int i = 0; i < 16; ++i) z[i] = 0.f;
        return; }
    typedef float f2 __attribute__((ext_vector_type(2)));
    f2 G2[2], PG2[2], zz[2][4];
#pragma unroll
    for (int kp = 0; kp < 2; ++kp) {
        f2 ee[4], ww[4];
#pragma unroll
        for (int r = 0; r < 4; ++r) {
            f2 zv = {z[4 * kp + r], z[4 * (kp + 2) + r]};
            zv = __builtin_elementwise_min(zv, (f2){30.f, 30.f});
            ee[r].x = ex2(zv.x); ee[r].y = ex2(zv.y);
            if (MODE == 1) { if ((8 * kp + 4 * hh + r) >= r32) ee[r].x = 0.f; if ((8 * (kp + 2) + 4 * hh + r) >= r32) ee[r].y = 0.f; }
            ww[r] = ee[r] + 1.0f;
        }
        const f2 p1 = ww[0], p2 = p1 * ww[1], p3 = p2 * ww[2], pp4 = p3 * ww[3];
        f2 R; R.x = __builtin_amdgcn_rcpf(pp4.x); R.y = __builtin_amdgcn_rcpf(pp4.y);
        zz[kp][0] = ee[0] * R; zz[kp][1] = ee[1] * (p1 * R); zz[kp][2] = ee[2] * (p2 * R); zz[kp][3] = ee[3] * (p3 * R);
        G2[kp] = R;
    }
#pragma unroll
    for (int kp = 0; kp < 2; ++kp) { PG2[kp].x = __shfl_xor(G2[kp].x, 32); PG2[kp].y = __shfl_xor(G2[kp].y, 32); }
    const float B3 = G2[1].y * PG2[1].y, B2 = G2[0].y * PG2[0].y, B1 = G2[1].x * PG2[1].x, B0 = G2[0].x * PG2[0].x;
    const float t3 = carry, t2 = t3 * B3, t1 = t2 * B2, t0 = t1 * B1;
    const bool lo = hh == 0;
    f2 off0, off1;
    off0.x = t0 * (lo ? PG2[0].x : 1.f); off0.y = t2 * (lo ? PG2[0].y : 1.f); off1.x = t1 * (lo ? PG2[1].x : 1.f); off1.y = t3 * (lo ? PG2[1].y : 1.f);
#pragma unroll
    for (int r = 0; r < 4; ++r) { const f2 a0 = zz[0][r] * off0, a1 = zz[1][r] * off1; z[r] = a0.x; z[8 + r] = a0.y; z[4 + r] = a1.x; z[12 + r] = a1.y; }
    carry = t0 * B0;
}
template <int MH> __device__ __forceinline__ void sb_pair(f32x16& zH, f32x16& zL, float& carry, int r32, int hh) {
    typedef float f2 __attribute__((ext_vector_type(2)));
    f2 GH[2], GL[2], PH[2], PL[2], aH[2][4], aL[2][4];
#pragma unroll
    for (int kp = 0; kp < 2; ++kp) {
        f2 eh[4], el[4], wh[4], wl[4];
#pragma unroll
        for (int r = 0; r < 4; ++r) {
            f2 vh = {zH[4 * kp + r], zH[4 * (kp + 2) + r]}, vl = {zL[4 * kp + r], zL[4 * (kp + 2) + r]};
            vh = __builtin_elementwise_min(vh, (f2){30.f, 30.f}); vl = __builtin_elementwise_min(vl, (f2){30.f, 30.f});
            eh[r].x = ex2(vh.x); eh[r].y = ex2(vh.y); el[r].x = ex2(vl.x); el[r].y = ex2(vl.y);
            if (MH == 1) { if ((8 * kp + 4 * hh + r) >= r32) eh[r].x = 0.f; if ((8 * (kp + 2) + 4 * hh + r) >= r32) eh[r].y = 0.f; }
            wh[r] = eh[r] + 1.0f; wl[r] = el[r] + 1.0f;
        }
        const f2 h1 = wh[0], h2 = h1 * wh[1], h3 = h2 * wh[2], h4 = h3 * wh[3], l1 = wl[0], l2 = l1 * wl[1], l3 = l2 * wl[2], l4 = l3 * wl[3];
        f2 RH, RL; RH.x = __builtin_amdgcn_rcpf(h4.x); RH.y = __builtin_amdgcn_rcpf(h4.y); RL.x = __builtin_amdgcn_rcpf(l4.x); RL.y = __builtin_amdgcn_rcpf(l4.y);
        aH[kp][0] = eh[0] * RH; aH[kp][1] = eh[1] * (h1 * RH); aH[kp][2] = eh[2] * (h2 * RH); aH[kp][3] = eh[3] * (h3 * RH);
        aL[kp][0] = el[0] * RL; aL[kp][1] = el[1] * (l1 * RL); aL[kp][2] = el[2] * (l2 * RL); aL[kp][3] = el[3] * (l3 * RL);
        GH[kp] = RH; GL[kp] = RL;
    }
#pragma unroll
    for (int kp = 0; kp < 2; ++kp) { PH[kp].x = __shfl_xor(GH[kp].x, 32); PH[kp].y = __shfl_xor(GH[kp].y, 32); PL[kp].x = __shfl_xor(GL[kp].x, 32); PL[kp].y = __shfl_xor(GL[kp].y, 32); }
    const bool lo = hh == 0;
    {
        const float B3 = GH[1].y * PH[1].y, B2 = GH[0].y * PH[0].y, B1 = GH[1].x * PH[1].x, B0 = GH[0].x * PH[0].x;
        const float t3 = carry, t2 = t3 * B3, t1 = t2 * B2, t0 = t1 * B1;
        f2 off0, off1; off0.x = t0 * (lo ? PH[0].x : 1.f); off0.y = t2 * (lo ? PH[0].y : 1.f); off1.x = t1 * (lo ? PH[1].x : 1.f); off1.y = t3 * (lo ? PH[1].y : 1.f);
#pragma unroll
        for (int r = 0; r < 4; ++r) { const f2 a0 = aH[0][r] * off0, a1 = aH[1][r] * off1; zH[r] = a0.x; zH[8 + r] = a0.y; zH[4 + r] = a1.x; zH[12 + r] = a1.y; }
        carry = t0 * B0; }
    {   const float B3 = GL[1].y * PL[1].y, B2 = GL[0].y * PL[0].y, B1 = GL[1].x * PL[1].x, B0 = GL[0].x * PL[0].x;
        const float t3 = carry, t2 = t3 * B3, t1 = t2 * B2, t0 = t1 * B1;
        f2 off0, off1; off0.x = t0 * (lo ? PL[0].x : 1.f); off0.y = t2 * (lo ? PL[0].y : 1.f); off1.x = t1 * (lo ? PL[1].x : 1.f); off1.y = t3 * (lo ? PL[1].y : 1.f);
#pragma unroll
        for (int r = 0; r < 4; ++r) { const f2 a0 = aL[0][r] * off0, a1 = aL[1][r] * off1; zL[r] = a0.x; zL[8 + r] = a0.y; zL[4 + r] = a1.x; zL[12 + r] = a1.y; }
        carry = t0 * B0; }
}
__device__ __forceinline__ void sb_pv(f32x16& o0, f32x16& o1, const f32x16& z, const LAS unsigned char* vb) {
    u32x4 p0, p1;
#pragma unroll
    for (int e = 0; e < 4; ++e) { p0[e] = pkbf(z[2 * e], z[2 * e + 1]); p1[e] = pkbf(z[8 + 2 * e], z[8 + 2 * e + 1]); }
    o0 = MFMA32(cat8(vtr(vb), vtr(vb + 8 * 144)), __builtin_bit_cast(bf16x8, p0), o0);
    o1 = MFMA32(cat8(vtr(vb + 64), vtr(vb + 8 * 144 + 64)), __builtin_bit_cast(bf16x8, p0), o1);
    o0 = MFMA32(cat8(vtr(vb + 16 * 144), vtr(vb + 24 * 144)), __builtin_bit_cast(bf16x8, p1), o0);
    o1 = MFMA32(cat8(vtr(vb + 16 * 144 + 64), vtr(vb + 24 * 144 + 64)), __builtin_bit_cast(bf16x8, p1), o1);
}
constexpr int SB_WT = 14, SB_ROWS = 448, SB_KS = 0, SB_VS = SB_ROWS * 144;
static_assert(SB_WT * 32 <= SB_ROWS && SB_ROWS * 8 == 7 * 512, "the staging loop writes exactly 448 rows (7 x 16-byte pieces per thread) per image");
__device__ __forceinline__ void sb_window_load(u32x4 (&kr)[7], u32x4 (&vr)[7], const char* Kp, const char* Vp, int wlo, int nrows, int tid) {
#pragma unroll
    for (int i = 0; i < 7; ++i) { const int id = tid + 512 * i, row = id >> 3; const int rr = row < nrows ? row : 0;
        const size_t off = (size_t)(wlo * 32 + rr) * 2048 + (id & 7) * 16; kr[i] = *(const u32x4*)(Kp + off); vr[i] = *(const u32x4*)(Vp + off); }
}
__device__ __forceinline__ void sb_phase(LAS unsigned char* lds, const bf16* Kb, const bf16* Vb, const bf16* Qb, bf16* Ob, int G, int bid) {
    const int tid = opaque_tid();
    const int lane = tid & 63, w = __builtin_amdgcn_readfirstlane(tid >> 6), r32 = lane & 31, hh = lane >> 5, q4 = (lane & 15) >> 2, p4 = lane & 3, gsel = (lane >> 4) & 1;
    LAS unsigned char* KS = lds + SB_KS; LAS unsigned char* VS = lds + SB_VS;
    const LAS unsigned char* ka_base = KS + r32 * 144 + 16 * hh;
    const LAS unsigned char* pv_base = VS + (4 * hh + q4) * 144 + (16 * gsel + 4 * p4) * 2;
    const unsigned koff = (unsigned)r32 * 2048u + 16u * hh;
    u32x4 kr[7], vr[7];
    int u = bid;
    if (u < 4096) { const int bh = u >> 5, qb = u & 31, whi = 8 * qb + 7, wlo = whi - (SB_WT - 1) > 0 ? whi - (SB_WT - 1) : 0;
        sb_window_load(kr, vr, (const char*)(Kb + (size_t)(bh >> 4) * SEQ * 1024 + (bh & 15) * 64), (const char*)(Vb + (size_t)(bh >> 4) * SEQ * 1024 + (bh & 15) * 64), wlo, (whi - wlo + 1) * 32, tid); }
    for (; u < 4096; u += G) {
        const int bh = u >> 5, qb = u & 31, b = bh >> 4, h = bh & 15, qt = qb * 8 + w;
        const char* Kp = (const char*)(Kb + (size_t)b * SEQ * 1024 + h * 64); const char* Vp = (const char*)(Vb + (size_t)b * SEQ * 1024 + h * 64);
        bf16x8 qf[4];
        { const char* qp = (const char*)(Qb + (size_t)b * SEQ * 1024 + h * 64) + (size_t)qt * (32 * 2048);
#pragma unroll
          for (int t = 0; t < 4; ++t) qf[t] = *(const bf16x8*)(qp + 32 * t + koff); }
        f32x16 o0, o1;
#pragma unroll
        for (int i = 0; i < 16; ++i) { o0[i] = 0.f; o1[i] = 0.f; }
        float carry = 1.f; int nt = qt; bool done = false;
        bool extra = false;
        for (int whi = 8 * qb + 7;;) {
            const int wlo = whi - (SB_WT - 1) > 0 ? whi - (SB_WT - 1) : 0;
            __syncthreads();
#pragma unroll
            for (int i = 0; i < 7; ++i) { const int id = tid + 512 * i; *(LAS u32x4*)(KS + (id >> 3) * 144 + (id & 7) * 16) = kr[i]; *(LAS u32x4*)(VS + (id >> 3) * 144 + (id & 7) * 16) = vr[i]; }
            __syncthreads();
            if (whi == 8 * qb + 7 && u + G < 4096) {
                const int u2 = u + G, bh2 = u2 >> 5, qb2 = u2 & 31, whi2 = 8 * qb2 + 7, wlo2 = whi2 - (SB_WT - 1) > 0 ? whi2 - (SB_WT - 1) : 0;
                sb_window_load(kr, vr, (const char*)(Kb + (size_t)(bh2 >> 4) * SEQ * 1024 + (bh2 & 15) * 64), (const char*)(Vb + (size_t)(bh2 >> 4) * SEQ * 1024 + (bh2 & 15) * 64), wlo2, (whi2 - wlo2 + 1) * 32, tid);
            }
            while (!done && nt >= wlo) {
                const int tH = nt, tL = nt - 1; const bool validL = tL >= wlo;
                const LAS unsigned char* kh = ka_base + (tH - wlo) * (32 * 144); const LAS unsigned char* kl = ka_base + ((validL ? tL : tH) - wlo) * (32 * 144);
                f32x16 zH, zL;
#pragma unroll
                for (int i = 0; i < 16; ++i) { zH[i] = 0.f; zL[i] = 0.f; }
#pragma unroll
                for (int t = 0; t < 4; ++t) { zH = MFMA32(*(const LAS bf16x8*)(kh + 32 * t), qf[t], zH); zL = MFMA32(*(const LAS bf16x8*)(kl + 32 * t), qf[t], zL); }
                if (validL) { if (tH == qt) sb_pair<1>(zH, zL, carry, r32, hh); else sb_pair<0>(zH, zL, carry, r32, hh); }
                else { if (tH == qt) sb_tile<1>(zH, carry, r32, hh); else sb_tile<0>(zH, carry, r32, hh); sb_tile<2>(zL, carry, r32, hh); }
                sb_pv(o0, o1, zH, pv_base + (tH - wlo) * (32 * 144));
                sb_pv(o0, o1, zL, pv_base + ((validL ? tL : tH) - wlo) * (32 * 144));
                nt -= validL ? 2 : 1;
                if (__builtin_amdgcn_ballot_w64(carry != 0.f) == 0ull || nt < 0) done = true;
            }
            if (nt < 0) done = true;
            if (!__syncthreads_or(done ? 0 : 1)) break;
            whi = wlo - 1;
            { const int wlo3 = whi - (SB_WT - 1) > 0 ? whi - (SB_WT - 1) : 0;
              extra = true; if (whi >= 0) sb_window_load(kr, vr, Kp, Vp, wlo3, (whi - wlo3 + 1) * 32, tid); }
        }
        if (extra && u + G < 4096) { const int u2 = u + G, bh2 = u2 >> 5, qb2 = u2 & 31, whi2 = 8 * qb2 + 7, wlo2 = whi2 - (SB_WT - 1) > 0 ? whi2 - (SB_WT - 1) : 0;
            sb_window_load(kr, vr, (const char*)(Kb + (size_t)(bh2 >> 4) * SEQ * 1024 + (bh2 & 15) * 64), (const char*)(Vb + (size_t)(bh2 >> 4) * SEQ * 1024 + (bh2 & 15) * 64), wlo2, (whi2 - wlo2 + 1) * 32, tid); }
        char* op = (char*)(Ob + (size_t)b * SEQ * 1024 + h * 64) + (size_t)qt * (32 * 2048) + (unsigned)r32 * 2048u + 8u * hh;
#pragma unroll
        for (int k = 0; k < 4; ++k) { u32x2 a0, a1; a0.x = pkbf(o0[4 * k], o0[4 * k + 1]); a0.y = pkbf(o0[4 * k + 2], o0[4 * k + 3]); a1.x = pkbf(o1[4 * k], o1[4 * k + 1]); a1.y = pkbf(o1[4 * k + 2], o1[4 * k + 3]);
            *(u32x2*)(op + 16 * k) = a0; *(u32x2*)(op + 64 + 16 * k) = a1; }
    }
}

__device__ __forceinline__ void final_norm_phase(float* out, const float* ssq, const float* g, int G, int bid) {
    const int tid = opaque_tid(), lane = tid & 63, gw = bid * NWAVES + __builtin_amdgcn_readfirstlane(tid >> 6), NGW = G * NWAVES;
    for (int m = gw; m < MTOK; m += NGW) {
        float s = lane < 16 ? ssq[(size_t)m * 16 + lane] : 0.f;
#pragma unroll
        for (int o = 1; o < 16; o <<= 1) s += __shfl_xor(s, o);
        s = __shfl(s, 0);
        const float rinv = 1.0f / sqrtf(s * (1.0f / 1024.0f) + 1e-6f);
        f32x4* xr = (f32x4*)(out + (size_t)m * DM) + lane; const f32x4* gr = (const f32x4*)g + lane;
#pragma unroll
        for (int j = 0; j < 4; ++j) xr[64 * j] = xr[64 * j] * rinv * gr[64 * j];
    }
}

__global__ void __launch_bounds__(NTHR, 2) yoco_fwd(Args a) {
    extern __shared__ __attribute__((aligned(16))) unsigned char lds_raw[];
    LAS unsigned char* lds = (LAS unsigned char*)lds_raw;
    cg::grid_group grid = cg::this_grid();
    const int G = gridDim.x, bid = blockIdx.x;
    unsigned char* ws = a.ws;
    bf16* XB = (bf16*)(ws + WS_XB); float* SSQ = (float*)(ws + WS_SSQ); float* out = a.out;
    const int lo = a.ph_lo, hi = a.ph_hi;
    volatile LAS unsigned* bst = (volatile LAS unsigned*)(lds + LDS_BARW);
    if (threadIdx.x < 2) bst[threadIdx.x] = 0u;
    __syncthreads();
    const XcdBarrier bar = xcd_barrier_post((unsigned*)(ws + WS_BAR), bst);
#ifndef PHM
#define PHM 0x1fff
#endif
#define IN(k) (((PHM >> (k)) & 1) && lo <= (k) && (k) < hi)
#define SEAM(k) do { if (lo <= (k) && (k) + 1 < hi) xcd_barrier(bar); } while (0)
#define GEMM_RESID(ph, AOFF, BOFF, KK, BASE, WANT) if (IN(ph)) { pg8::Gemm g{(const bf16*)(ws + (AOFF)), (const bf16*)(ws + (BOFF)), MTOK, 1024, (KK)}; pg8::StaticOrder S; S.init(MTOK, 1024, G, bid); \
        pg8::EpiNorm<false> E{(BASE), out, XB, nullptr, (float*)(ws + WS_STATS), (unsigned*)(ws + WS_BAR + 65536), (WANT), (LAS float*)(lds + 131072), (LAS float*)(lds + 131072 + 4096)}; \
        pg8::gemm_phase<pg8::EpiNorm<false>, pg8::StaticOrder, true, true>(lds, g, S, E); }
#define GEMM_FFNIN(ph, BOFF) if (IN(ph)) { pg8::Gemm g{XB, (const bf16*)(ws + (BOFF)), MTOK, 2 * DFF, 1024}; pg8::StaticOrder S; S.init(MTOK, 2 * DFF, G, bid); \
        pg8::EpiSwiGLU E{(bf16*)(ws + WS_HID), SSQ}; pg8::gemm_phase<pg8::EpiSwiGLU, pg8::StaticOrder, true, true>(lds, g, S, E); }
    if (hi > 64) grid.sync();
    if (IN(0)) prologue(a, lds, G, bid);
    SEAM(0);
#define PHASE1 if (IN(1)) { pg8::Gemm g{XB, (const bf16*)(ws + WS_WRI), MTOK, 6144, 1024}; pg8::StaticOrder S; S.init(MTOK, 6144, G, bid); \
        pg8::EpiProj E{(bf16*)(ws + WS_RQ), (bf16*)(ws + WS_RV), SSQ}; pg8::gemm_phase<pg8::EpiProj, pg8::StaticOrder, true, true>(lds, g, S, E); }
#define PHASE2 if (IN(2)) { ret_scores_phase(lds, (const bf16*)(ws + WS_RQ), (const bf16*)(ws + WS_RK), (unsigned char*)out, G, bid); xcd_barrier(bar); \
        retention_phase(lds, (const bf16*)(ws + WS_RQ), (const bf16*)(ws + WS_RK), (bf16*)(ws + WS_RV), (const unsigned char*)out, (float*)(ws + WS_STATS), (unsigned*)(ws + WS_BAR) + 3600, G, bid); }
    PHASE1
    SEAM(1);
    PHASE2
    SEAM(2);
    if (IN(3)) gngate_phase((const bf16*)(ws + WS_RV), (const bf16*)(ws + WS_RG), (bf16*)(ws + WS_RY), (const float*)(ws + WS_STATS), a.in[3], G, bid);
    SEAM(3);
    GEMM_RESID(4, WS_RY, WS_WRO, 2048, a.in[0], 16u)
    SEAM(4);
    GEMM_FFNIN(5, WS_WFI0)
    SEAM(5);
    GEMM_RESID(6, WS_HID, WS_WFO0, DFF, (const float*)out, 32u)
    SEAM(6);
    if (IN(7)) { pg8::Gemm g{XB, (const bf16*)(ws + WS_WKVQ), MTOK, 3072, 1024}; pg8::StaticOrder S; S.init(MTOK, 3072, G, bid);
        pg8::EpiKVQ E{(bf16*)(ws + WS_SK), SSQ, 0.125f * 1.4426950408889634f}; pg8::gemm_phase<pg8::EpiKVQ, pg8::StaticOrder, true, true>(lds, g, S, E); }
    SEAM(7);
    if (IN(8)) sb_phase(lds, (const bf16*)(ws + WS_SK), (const bf16*)(ws + WS_SV), (const bf16*)(ws + WS_SQ), (bf16*)(ws + WS_SO), G, bid);
    SEAM(8);
    GEMM_RESID(9, WS_SO, WS_WSO, 1024, (const float*)out, 48u)
    SEAM(9);
    GEMM_FFNIN(10, WS_WFI1)
    SEAM(10);
    if (IN(11)) { pg8::Gemm g{(const bf16*)(ws + WS_HID), (const bf16*)(ws + WS_WFO1), MTOK, 1024, DFF}; pg8::StaticOrder S; S.init(MTOK, 1024, G, bid);
        pg8::EpiNorm<true> E{(const float*)out, out, nullptr, a.in[12], (float*)(ws + WS_STATS), (unsigned*)(ws + WS_BAR + 65536), 64u, (LAS float*)(lds + 131072), (LAS float*)(lds + 131072 + 4096)};
        pg8::gemm_phase<pg8::EpiNorm<true>, pg8::StaticOrder, true, true>(lds, g, S, E); }
}

extern "C" void kernel_launch(void* const* d_in, const int* in_sizes, int n_in, void* d_out, int out_size, void* d_ws, size_t ws_size, hipStream_t stream) {
    static int grid = 0;
    if (grid == 0) {
        if (n_in != 13 || out_size != MTOK * DM || ws_size < WS_END) { fprintf(stderr, "kernel_launch: unexpected shapes / workspace (%d inputs, out %d, ws %zu)\n", n_in, out_size, ws_size); grid = -1; return; }
        int dev = 0, cus = 0, per_cu = 0;
        (void)hipGetDevice(&dev); (void)hipDeviceGetAttribute(&cus, hipDeviceAttributeMultiprocessorCount, dev);
        (void)hipFuncSetAttribute((const void*)yoco_fwd, hipFuncAttributeMaxDynamicSharedMemorySize, LDS_BYTES);
        (void)hipOccupancyMaxActiveBlocksPerMultiprocessor(&per_cu, (const void*)yoco_fwd, NTHR, LDS_BYTES);
        if (per_cu < 1) per_cu = 1;
        grid = cus * per_cu;
        (void)hipGetLastError();
    }
    if (grid < 0) return;
    Args a{};
    for (int i = 0; i < 13; ++i) a.in[i] = (const float*)d_in[i];
    a.out = (float*)d_out; a.ws = (unsigned char*)d_ws; a.ph_lo = 0; a.ph_hi = 12;
    (void)hipMemsetAsync((char*)d_ws + WS_BAR, 0, BAR_BYTES, stream);
    void* args[] = {&a};
    hipError_t e = hipLaunchCooperativeKernel((const void*)yoco_fwd, dim3(grid), dim3(NTHR), args, LDS_BYTES, stream);
    if (e != hipSuccess) fprintf(stderr, "cooperative launch failed: %s (grid %d)\n", hipGetErrorString(e), grid);
}
```

```cpp
#include <hip/hip_runtime.h>
#include <hip/hip_cooperative_groups.h>
#include <cstdio>
#include <cstdint>
namespace cg = cooperative_groups;
typedef float f32x2v __attribute__((ext_vector_type(2)));
namespace pg8 {
#define PG8_LAS __attribute__((address_space(3)))
typedef unsigned short bf16_t;
typedef short bf16x8 __attribute__((ext_vector_type(8)));
typedef float f32x4 __attribute__((ext_vector_type(4)));
typedef unsigned u32x4 __attribute__((ext_vector_type(4)));
constexpr int BM = 256, BK = 64, HALF = 128, HTB = HALF * BK * 2  , STAGE_BYTES = 8 * HTB, NXCD = 8, WGM = 8;

__host__ __device__ __forceinline__ int lds_byte(int r, int c) { const int st = (r >> 4) * 2 + (c >> 5), rr = r & 15, cc = c & 31, ob = rr * 64 + cc * 2; return st * 1024 + (ob ^ (((ob >> 9) & 1) << 5)); }
__host__ __device__ __forceinline__ void stage_rc(int b, int& R, int& C) { const int st = b / 1024, sb = b % 1024, swz = sb ^ (((sb >> 9) & 1) << 5); R = (st >> 1) * 16 + swz / 64; C = (st & 1) * 32 + (swz % 64) / 2; }
__host__ __device__ __forceinline__ int perm32(int rho) { const int n = rho >> 4, i = rho & 15; return 8 * (i >> 2) + 4 * n + (i & 3); }

struct Unit { int pm, pn; };
struct Gemm { const bf16_t* A; const bf16_t* Bt; int M, N, K; };

struct StaticOrder {
    int nM, nN, nwg, G, c;
    __host__ __device__ void init(int M, int N, int G_, int c_) { nM = M / BM; nN = N / BM; nwg = nM * nN; G = G_; c = c_; }
    __host__ __device__ bool next(int i, Unit& u) const {
        const long L = (long)i * G + c; if (L >= nwg) return false;
        int wgid = (int)L; { const int q = nwg / NXCD, r = nwg % NXCD, xcd = wgid % NXCD, off = wgid / NXCD; wgid = (xcd < r ? xcd * (q + 1) : r * (q + 1) + (xcd - r) * q) + off; }
        const int nig = WGM * nN, gid = wgid / nig, fm = gid * WGM, gsz = (nM - fm) < WGM ? (nM - fm) : WGM;
        u.pm = fm + ((wgid % nig) % gsz); u.pn = (wgid % nig) / gsz; return true;
    }
    __device__ __forceinline__ void a_ready(const Unit&) const {}
    __device__ __forceinline__ void done(const Unit&) const {}
};
typedef __bf16 bf16x2n __attribute__((ext_vector_type(2)));
typedef float f32x2n __attribute__((ext_vector_type(2)));
__device__ __forceinline__ unsigned cvt_pk_bf16(float lo, float hi) { const f32x2n v = {lo, hi}; return __builtin_bit_cast(unsigned, __builtin_convertvector(v, bf16x2n)); }
typedef float f32x2 __attribute__((ext_vector_type(2)));
__device__ __forceinline__ float row_rinv1(const float* ssq, int row, int fq) {
    const f32x4 p = *(const f32x4*)(ssq + (size_t)row * 16 + 4 * fq);
    float s = (p[0] + p[1]) + (p[2] + p[3]);
    s += __shfl_xor(s, 16); s += __shfl_xor(s, 32);
    return __builtin_amdgcn_rsqf(s * (1.0f / 1024.0f) + 1e-6f);
}
__device__ __forceinline__ u32x4 pack8(const f32x4 a, const f32x4 b) { u32x4 w; w.x = cvt_pk_bf16(a[0], a[1]); w.y = cvt_pk_bf16(a[2], a[3]); w.z = cvt_pk_bf16(b[0], b[1]); w.w = cvt_pk_bf16(b[2], b[3]); return w; }

struct EpiProj {
    static constexpr bool PERM = true, AFTER_DRAIN = false;
    bf16_t *q, *v; const float* ssq;
    __device__ __forceinline__ void operator()(const f32x4 (&acc)[2][2][4][2], const Unit& u, int wr, int wc, int fr, int fq) const {
        const int pn = u.pn;
        if (pn < 8) {
            bf16_t* base = q + (size_t)(pn >> 2) * ((size_t)64 << 20) + (pn & 3) * 256 + wc * 32 + 8 * fq; const float sc = pn < 4 ? 1.0f : 0.0625f;
            const float lgs = __builtin_amdgcn_logf(1.0f - __builtin_amdgcn_exp2f(-5.0f - (float)(pn & 3))) * (pn < 4 ? 1.0f : -1.0f);
            float invf[2][4];
#pragma unroll
            for (int n = 0; n < 2; ++n)
#pragma unroll
                for (int e = 0; e < 4; ++e) invf[n][e] = __builtin_amdgcn_exp2f(-(float)(32 * wc + 8 * fq + 4 * n + e) * (13.287712379549449f / 128.0f)) * 0.15915494309189535f;
#pragma unroll
            for (int ai = 0; ai < 2; ++ai)
#pragma unroll
                for (int m = 0; m < 4; ++m) {
                    const int row = u.pm * BM + ai * HALF + wr * 64 + m * 16 + fr; const float pos = (float)(row & 8191), r = sc * __builtin_amdgcn_exp2f((float)(row & 127) * lgs);
                    f32x4 o1[2], o2[2];
#pragma unroll
                    for (int n = 0; n < 2; ++n) { const f32x4 t1 = acc[ai][0][m][n] * r, t2 = acc[ai][1][m][n] * r;
#pragma unroll
                        for (int e = 0; e < 4; ++e) { const float fx = __builtin_amdgcn_fractf(pos * invf[n][e]); const float s = __builtin_amdgcn_sinf(fx), c = __builtin_amdgcn_cosf(fx);
                            o1[n][e] = t1[e] * c - t2[e] * s; o2[n][e] = t1[e] * s + t2[e] * c; } }
                    if (pn < 4) {
                        const int s_ = row & 8191, d0 = wc * 32 + 8 * fq; const size_t it4 = ((size_t)(((row >> 13) * 4 + pn) * 64 + (s_ >> 7)) * 4 + ((s_ >> 5) & 3)) * 16;
                        bf16_t* f0 = q + ((it4 + (d0 >> 4)) * 64 + (fq & 1) * 32 + (s_ & 31)) * 8;
                        *(u32x4*)f0 = pack8(o1[0], o1[1]); *(u32x4*)(f0 + 8 * 64 * 8) = pack8(o2[0], o2[1]);
                    } else { bf16_t* rowp = base + (size_t)row * 1024; *(u32x4*)(rowp) = pack8(o1[0], o1[1]); *(u32x4*)(rowp + 128) = pack8(o2[0], o2[1]); }
                }
        } else {
            bf16_t* base = v + (size_t)((pn - 8) >> 3) * ((size_t)128 << 20) + (pn & 7) * 256 + wc * 32 + 8 * fq;
#pragma unroll
            for (int ai = 0; ai < 2; ++ai)
#pragma unroll
                for (int m = 0; m < 4; ++m) {
                    const int row = u.pm * BM + ai * HALF + wr * 64 + m * 16 + fr; bf16_t* rowp = base + (size_t)row * 2048;
#pragma unroll
                    for (int bj = 0; bj < 2; ++bj) *(u32x4*)(rowp + bj * HALF) = pack8(acc[ai][bj][m][0], acc[ai][bj][m][1]);
                }
        }
    }
};
struct EpiSwiGLU {
    static constexpr bool PERM = true, AFTER_DRAIN = false;
    bf16_t* H; const float* ssq;
    __device__ __forceinline__ void operator()(const f32x4 (&acc)[2][2][4][2], const Unit& u, int wr, int wc, int fr, int fq) const {
        bf16_t* base = H + u.pn * 128 + wc * 32 + 8 * fq;
#pragma unroll
        for (int ai = 0; ai < 2; ++ai)
#pragma unroll
            for (int m = 0; m < 4; ++m) {
                const int row = u.pm * BM + ai * HALF + wr * 64 + m * 16 + fr;
                f32x4 hv[2];
#pragma unroll
                for (int n = 0; n < 2; ++n) { const f32x4 gt = acc[ai][0][m][n], up = acc[ai][1][m][n];
#pragma unroll
                    for (int e = 0; e < 4; ++e) hv[n][e] = gt[e] * __builtin_amdgcn_rcpf(1.0f + __builtin_amdgcn_exp2f(-1.4426950408889634f * gt[e])) * up[e]; }
                *(u32x4*)(base + (size_t)row * 2816) = pack8(hv[0], hv[1]);
            }
    }
};
struct EpiKVQ {
    static constexpr bool PERM = true, AFTER_DRAIN = false;
    bf16_t *K; const float* ssq; float qscale;
    __device__ __forceinline__ void operator()(const f32x4 (&acc)[2][2][4][2], const Unit& u, int wr, int wc, int fr, int fq) const {
        const int pn = u.pn; const float sc = pn < 8 ? 1.0f : qscale;
        bf16_t* base = K + (size_t)(pn >> 2) * ((size_t)64 << 20) + (pn & 3) * 256 + wc * 32 + 8 * fq;
#pragma unroll
        for (int ai = 0; ai < 2; ++ai)
#pragma unroll
            for (int m = 0; m < 4; ++m) {
                const int row = u.pm * BM + ai * HALF + wr * 64 + m * 16 + fr; const float r = sc; bf16_t* rowp = base + (size_t)row * 1024;
#pragma unroll
                for (int bj = 0; bj < 2; ++bj) *(u32x4*)(rowp + bj * HALF) = pack8(acc[ai][bj][m][0] * r, acc[ai][bj][m][1] * r);
            }
    }
};
struct EpiResid {
    static constexpr bool PERM = true, AFTER_DRAIN = false;
    const float* base; float* out; bf16_t* xb; float* ssq;
    __device__ __forceinline__ void operator()(const f32x4 (&acc)[2][2][4][2], const Unit& u, int wr, int wc, int fr, int fq) const {
#pragma unroll
        for (int ai = 0; ai < 2; ++ai)
#pragma unroll
            for (int m = 0; m < 4; ++m) {
                const int row = u.pm * BM + ai * HALF + wr * 64 + m * 16 + fr; const size_t off = (size_t)row * 1024 + u.pn * BM + wc * 32 + 8 * fq; float ss = 0.f;
#pragma unroll
                for (int bj = 0; bj < 2; ++bj) {
                    const f32x4 x0 = *(const f32x4*)(base + off + bj * HALF) + acc[ai][bj][m][0], x1 = *(const f32x4*)(base + off + bj * HALF + 4) + acc[ai][bj][m][1];
                    *(f32x4*)(out + off + bj * HALF) = x0; *(f32x4*)(out + off + bj * HALF + 4) = x1;
                    ss += (x0[0] * x0[0] + x0[1] * x0[1]) + (x0[2] * x0[2] + x0[3] * x0[3]) + (x1[0] * x1[0] + x1[1] * x1[1]) + (x1[2] * x1[2] + x1[3] * x1[3]);
                    *(u32x4*)(xb + off + bj * HALF) = pack8(x0, x1);
                }
                ss += __shfl_xor(ss, 16); ss += __shfl_xor(ss, 32);
                if (fq == 0) ssq[(size_t)row * 16 + 4 * u.pn + wc] = ss;
            }
    }
};

template <bool FINAL> struct EpiNorm {
    static constexpr bool PERM = true, AFTER_DRAIN = false;
    const float* base; float* out; bf16_t* xb; const float* g; float* xsum; unsigned* cnt; unsigned want; PG8_LAS float* P; PG8_LAS float* S;
    __device__ __forceinline__ void operator()(f32x4 (&acc)[2][2][4][2], const Unit& u, int wr, int wc, int fr, int fq) const {
        const int tid = threadIdx.x, lane = tid & 63, wid = __builtin_amdgcn_readfirstlane(tid >> 6);
        __builtin_amdgcn_sched_barrier(0);
#pragma unroll
        for (int ai = 0; ai < 2; ++ai) {
            f32x4 bt[4][2][2];
#pragma unroll
            for (int m = 0; m < 4; ++m) {
                const size_t off = (size_t)(u.pm * BM + ai * HALF + wr * 64 + m * 16 + fr) * 1024 + u.pn * BM + wc * 32 + 8 * fq;
#pragma unroll
                for (int bj = 0; bj < 2; ++bj) { bt[m][bj][0] = *(const f32x4*)(base + off + bj * HALF); bt[m][bj][1] = *(const f32x4*)(base + off + bj * HALF + 4); }
            }
            __builtin_amdgcn_sched_barrier(0);
#pragma unroll
            for (int m = 0; m < 4; ++m) {
                const int rl = ai * HALF + wr * 64 + m * 16 + fr; const size_t off = (size_t)(u.pm * BM + rl) * 1024 + u.pn * BM + wc * 32 + 8 * fq; float ss = 0.f;
#pragma unroll
                for (int bj = 0; bj < 2; ++bj) {
                    const f32x4 x0 = bt[m][bj][0] + acc[ai][bj][m][0], x1 = bt[m][bj][1] + acc[ai][bj][m][1];
                    acc[ai][bj][m][0] = x0; acc[ai][bj][m][1] = x1;
                    ss += (x0[0] * x0[0] + x0[1] * x0[1]) + (x0[2] * x0[2] + x0[3] * x0[3]) + (x1[0] * x1[0] + x1[1] * x1[1]) + (x1[2] * x1[2] + x1[3] * x1[3]);
                }
                ss += __shfl_xor(ss, 16); ss += __shfl_xor(ss, 32);
                if (fq == 0) P[rl * 4 + wc] = ss;
            }
            __builtin_amdgcn_sched_barrier(0);
        }
        asm volatile("s_waitcnt lgkmcnt(0)" ::: "memory"); __builtin_amdgcn_s_barrier(); asm volatile("" ::: "memory");
        if (tid < 256) {
            const float s = (P[tid * 4 + 0] + P[tid * 4 + 1]) + (P[tid * 4 + 2] + P[tid * 4 + 3]);
            __hip_atomic_store(xsum + (size_t)(u.pm * BM + tid) * 4 + u.pn, s, __ATOMIC_RELAXED, __HIP_MEMORY_SCOPE_AGENT);
            asm volatile("s_waitcnt vmcnt(0)" ::: "memory");
            if (lane == 0) __hip_atomic_fetch_add(cnt + 64 * u.pm, 1u, __ATOMIC_RELAXED, __HIP_MEMORY_SCOPE_AGENT);
        }
        if (wid == 0) {
            unsigned spins = 0;
            while ((unsigned)__builtin_amdgcn_readfirstlane(__hip_atomic_load(cnt + 64 * u.pm, __ATOMIC_RELAXED, __HIP_MEMORY_SCOPE_AGENT)) < want) { __builtin_amdgcn_s_sleep(2); if (++spins > (1u << 24)) break; }
            __builtin_amdgcn_fence(__ATOMIC_ACQUIRE, "agent");
        }
        asm volatile("s_waitcnt vmcnt(0) lgkmcnt(0)" ::: "memory"); __builtin_amdgcn_s_barrier(); asm volatile("" ::: "memory");
        if (tid < 256) {
            const float* sl = xsum + (size_t)(u.pm * BM + tid) * 4;
            const float t = (__hip_atomic_load(sl, __ATOMIC_RELAXED, __HIP_MEMORY_SCOPE_AGENT) + __hip_atomic_load(sl + 1, __ATOMIC_RELAXED, __HIP_MEMORY_SCOPE_AGENT)) +
                            (__hip_atomic_load(sl + 2, __ATOMIC_RELAXED, __HIP_MEMORY_SCOPE_AGENT) + __hip_atomic_load(sl + 3, __ATOMIC_RELAXED, __HIP_MEMORY_SCOPE_AGENT));
            S[tid] = 1.0f / sqrtf(t * (1.0f / 1024.0f) + 1e-6f);
        }
        asm volatile("s_waitcnt vmcnt(0) lgkmcnt(0)" ::: "memory"); __builtin_amdgcn_s_barrier(); asm volatile("" ::: "memory");
        f32x4 gv[2][2];
        if (FINAL) {
#pragma unroll
            for (int bj = 0; bj < 2; ++bj) { gv[bj][0] = *(const f32x4*)(g + u.pn * BM + bj * HALF + wc * 32 + 8 * fq); gv[bj][1] = *(const f32x4*)(g + u.pn * BM + bj * HALF + wc * 32 + 8 * fq + 4); } }
#pragma unroll
        for (int ai = 0; ai < 2; ++ai)
#pragma unroll
            for (int m = 0; m < 4; ++m) {
                const int rl = ai * HALF + wr * 64 + m * 16 + fr; const size_t off = (size_t)(u.pm * BM + rl) * 1024 + u.pn * BM + wc * 32 + 8 * fq; const float r = S[rl];
#pragma unroll
                for (int bj = 0; bj < 2; ++bj) {
                    if (FINAL) { *(f32x4*)(out + off + bj * HALF) = acc[ai][bj][m][0] * r * gv[bj][0]; *(f32x4*)(out + off + bj * HALF + 4) = acc[ai][bj][m][1] * r * gv[bj][1]; }
                    else { *(f32x4*)(out + off + bj * HALF) = acc[ai][bj][m][0]; *(f32x4*)(out + off + bj * HALF + 4) = acc[ai][bj][m][1];
                           *(u32x4*)(xb + off + bj * HALF) = pack8(acc[ai][bj][m][0] * r, acc[ai][bj][m][1] * r); }
                }
            }
        asm volatile("s_waitcnt lgkmcnt(0)" ::: "memory"); __builtin_amdgcn_s_barrier(); asm volatile("" ::: "memory");
    }
};
template <class Epi, class Sched, bool ALIGN_EPI = false, bool SP2 = false>
__device__ __forceinline__ void gemm_phase(PG8_LAS unsigned char* lds, const Gemm g, const Sched& S, const Epi& E) {
    const int tid = threadIdx.x, wid = __builtin_amdgcn_readfirstlane(tid >> 6), lane = tid & 63, wr = wid >> 2, wc = wid & 3, fr = lane & 15, fq = lane >> 4;
    const int K = g.K, nt = K / BK;
    unsigned voffA[2], voffB[2];
#pragma unroll
    for (int i = 0; i < 2; ++i) { int R, C; stage_rc(tid * 16 + i * 8192, R, C); const int Rb = Epi::PERM ? ((R & ~31) + perm32(R & 31)) : R;
        voffA[i] = (unsigned)(R * K + C) * 2u; voffB[i] = (unsigned)(Rb * K + C) * 2u; }
    const size_t kstep = (size_t)(BK * 2);
    const size_t hstep = (size_t)HALF * K * 2;
    const size_t tstep = 2 * hstep;
    const unsigned ldsw = (unsigned)wid * 1024u;
    const int aoff = lds_byte(wr * 64 + fr, fq * 8), boff = lds_byte(wc * 32 + fr, fq * 8);
#define PG8_SA(b, h) (((b) * 2 + (h)) * HTB)
#define PG8_SB(b, h) ((4 + (b) * 2 + (h)) * HTB)
#define PG8_STAGE(bufoff, gbase, voff) do { _Pragma("unroll") for (int _i = 0; _i < 2; ++_i) \
        __builtin_amdgcn_global_load_lds((const unsigned*)((const char*)(gbase) + (voff)[_i]), (PG8_LAS unsigned*)(lds + (bufoff) + ldsw + _i * 8192), 16, 0, 0); } while (0)
#define PG8_LDA(dst, b, h) do { _Pragma("unroll") for (int m = 0; m < 4; ++m) _Pragma("unroll") for (int k = 0; k < 2; ++k) dst[m][k] = *(const PG8_LAS bf16x8*)(lds + PG8_SA(b, h) + aoff + m * 2048 + k * 1024); } while (0)
#define PG8_LDB(dst, b, h) do { _Pragma("unroll") for (int n = 0; n < 2; ++n) _Pragma("unroll") for (int k = 0; k < 2; ++k) dst[n][k] = *(const PG8_LAS bf16x8*)(lds + PG8_SB(b, h) + boff + n * 2048 + k * 1024); } while (0)
#define PG8_MMA(ai, bj, At, Bt) do { __builtin_amdgcn_s_setprio(1); _Pragma("unroll") for (int m = 0; m < 4; ++m) _Pragma("unroll") for (int n = 0; n < 2; ++n) _Pragma("unroll") for (int k = 0; k < 2; ++k) \
        acc[ai][bj][m][n] = __builtin_amdgcn_mfma_f32_16x16x32_bf16(Bt[n][k], At[m][k], acc[ai][bj][m][n], 0, 0, 0); __builtin_amdgcn_s_setprio(0); } while (0)
#define PG8_WAIT_V(n) asm volatile("s_waitcnt vmcnt(" #n ")" ::: "memory")
#define PG8_WAIT_L(n) asm volatile("s_waitcnt lgkmcnt(" #n ")" ::: "memory")
#define PG8_BAR __builtin_amdgcn_s_barrier()
#define PG8_SCHED __builtin_amdgcn_sched_barrier(0)
    Unit cur, nxt; int ui = 0;
    if (!S.next(0, cur)) return;
    f32x4 acc[2][2][4][2];
#pragma unroll
    for (int a = 0; a < 2; ++a)
#pragma unroll
        for (int b = 0; b < 2; ++b)
#pragma unroll
            for (int m = 0; m < 4; ++m)
#pragma unroll
                for (int n = 0; n < 2; ++n) acc[a][b][m][n] = (f32x4){0.f, 0.f, 0.f, 0.f};
    bf16x8 At[4][2], B0[2][2], B1[2][2];
    const char* cA = (const char*)g.A + (size_t)cur.pm * tstep; const char* cB = (const char*)g.Bt + (size_t)cur.pn * tstep;
    S.a_ready(cur);
    if constexpr (SP2) {
        PG8_STAGE(PG8_SB(0, 0), cB, voffB); PG8_STAGE(PG8_SB(0, 1), cB + hstep, voffB); PG8_STAGE(PG8_SA(0, 0), cA, voffA); PG8_STAGE(PG8_SA(0, 1), cA + hstep, voffA);
        if (wr == 1) PG8_BAR;
        PG8_WAIT_V(2); PG8_BAR;
        PG8_STAGE(PG8_SB(1, 0), cB + kstep, voffB); PG8_STAGE(PG8_SA(1, 0), cA + kstep, voffA); PG8_STAGE(PG8_SB(1, 1), cB + hstep + kstep, voffB);
        PG8_WAIT_V(6); PG8_BAR;
    } else {
        PG8_STAGE(PG8_SB(0, 0), cB, voffB); PG8_STAGE(PG8_SA(0, 0), cA, voffA); PG8_STAGE(PG8_SB(0, 1), cB + hstep, voffB); PG8_STAGE(PG8_SA(0, 1), cA + hstep, voffA);
        if (wr == 1) PG8_BAR;
        PG8_WAIT_V(4); PG8_BAR;
        PG8_STAGE(PG8_SB(1, 0), cB + kstep, voffB); PG8_STAGE(PG8_SA(1, 0), cA + kstep, voffA); PG8_STAGE(PG8_SB(1, 1), cB + hstep + kstep, voffB);
        PG8_WAIT_V(6); PG8_BAR;
    }
    for (;;) {
        const bool has_next = S.next(ui + 1, nxt);
        const char* nA = has_next ? (const char*)g.A + (size_t)nxt.pm * tstep : cA; const char* nB = has_next ? (const char*)g.Bt + (size_t)nxt.pn * tstep : cB;
        for (int t = 0; t < nt; t += 2) {
            const bool last = (t == nt - 2);
            const char* a1 = cA + (size_t)(t + 1) * kstep;
            const char* a2 = last ? nA : cA + (size_t)(t + 2) * kstep; const char* b2 = last ? nB : cB + (size_t)(t + 2) * kstep;
            const char* a3 = a2 + kstep; const char* b3 = b2 + kstep;
            if (last && has_next) S.a_ready(nxt);
            if constexpr (SP2) {
            PG8_LDB(B0, 0, 0); PG8_LDB(B1, 0, 1); PG8_SCHED; PG8_LDA(At, 0, 0); PG8_STAGE(PG8_SA(1, 1), a1 + hstep, voffA);
            PG8_WAIT_V(8); PG8_WAIT_L(0); PG8_BAR; PG8_MMA(0, 0, At, B0); PG8_MMA(0, 1, At, B1); PG8_BAR; PG8_SCHED;
            PG8_LDA(At, 0, 1); PG8_STAGE(PG8_SB(0, 0), b2, voffB); PG8_STAGE(PG8_SB(0, 1), b2 + hstep, voffB); PG8_STAGE(PG8_SA(0, 0), a2, voffA);
            PG8_WAIT_V(8); PG8_WAIT_L(0); PG8_BAR; PG8_MMA(1, 0, At, B0); PG8_MMA(1, 1, At, B1); PG8_BAR; PG8_SCHED;
            PG8_LDB(B0, 1, 0); PG8_LDB(B1, 1, 1); PG8_SCHED; PG8_LDA(At, 1, 0); PG8_STAGE(PG8_SA(0, 1), a2 + hstep, voffA);
            PG8_WAIT_V(8); PG8_WAIT_L(0); PG8_BAR; PG8_MMA(0, 0, At, B0); PG8_MMA(0, 1, At, B1); PG8_BAR; PG8_SCHED;
            PG8_LDA(At, 1, 1); PG8_STAGE(PG8_SB(1, 0), b3, voffB); PG8_STAGE(PG8_SB(1, 1), b3 + hstep, voffB); PG8_STAGE(PG8_SA(1, 0), a3, voffA);
            PG8_WAIT_V(8); PG8_WAIT_L(0); PG8_BAR; PG8_MMA(1, 0, At, B0); PG8_MMA(1, 1, At, B1); PG8_BAR; PG8_SCHED;
            } else {
            PG8_LDB(B0, 0, 0); PG8_SCHED; PG8_LDA(At, 0, 0); PG8_STAGE(PG8_SA(1, 1), a1 + hstep, voffA);
            PG8_WAIT_L(8); PG8_BAR; PG8_WAIT_L(0); PG8_MMA(0, 0, At, B0); PG8_BAR; PG8_SCHED;
            PG8_LDB(B1, 0, 1); PG8_STAGE(PG8_SB(0, 0), b2, voffB);
            PG8_BAR; PG8_WAIT_L(0); PG8_MMA(0, 1, At, B1); PG8_BAR;
            PG8_LDA(At, 0, 1); PG8_STAGE(PG8_SA(0, 0), a2, voffA);
            PG8_BAR; PG8_WAIT_L(0); PG8_MMA(1, 0, At, B0); PG8_BAR; PG8_SCHED;
            PG8_STAGE(PG8_SB(0, 1), b2 + hstep, voffB);
            PG8_WAIT_V(6); PG8_BAR; PG8_MMA(1, 1, At, B1); PG8_BAR;
            PG8_LDB(B0, 1, 0); PG8_SCHED; PG8_LDA(At, 1, 0); PG8_STAGE(PG8_SA(0, 1), a2 + hstep, voffA);
            PG8_WAIT_L(8); PG8_BAR; PG8_WAIT_L(0); PG8_MMA(0, 0, At, B0); PG8_BAR; PG8_SCHED;
            PG8_LDB(B1, 1, 1); PG8_STAGE(PG8_SB(1, 0), b3, voffB);
            PG8_BAR; PG8_WAIT_L(0); PG8_MMA(0, 1, At, B1); PG8_BAR;
            PG8_LDA(At, 1, 1); PG8_STAGE(PG8_SA(1, 0), a3, voffA);
            PG8_BAR; PG8_WAIT_L(0); PG8_MMA(1, 0, At, B0); PG8_BAR; PG8_SCHED;
            PG8_STAGE(PG8_SB(1, 1), b3 + hstep, voffB);
            PG8_WAIT_V(6); PG8_BAR; PG8_MMA(1, 1, At, B1); PG8_BAR;
            }
        }
        if constexpr (ALIGN_EPI) { if (wr == 0) PG8_BAR; }
        if constexpr (!Epi::AFTER_DRAIN) { E(acc, cur, wr, wc, fr, fq); S.done(cur); }
        if (!has_next) break;
#pragma unroll
        for (int a = 0; a < 2; ++a)
#pragma unroll
            for (int b = 0; b < 2; ++b)
#pragma unroll
                for (int m = 0; m < 4; ++m)
#pragma unroll
                    for (int n = 0; n < 2; ++n) acc[a][b][m][n] = (f32x4){0.f, 0.f, 0.f, 0.f};
        cur = nxt; cA = nA; cB = nB; ++ui;
        if constexpr (ALIGN_EPI) { if (wr == 1) PG8_BAR; }
    }
    PG8_WAIT_V(0);
    if constexpr (!ALIGN_EPI) { if (wr == 0) PG8_BAR; }
    PG8_BAR;
    if constexpr (Epi::AFTER_DRAIN) { E.fused(acc, cur, wr, wc, fr, fq, lds, wid, lane); S.done(cur); }
#undef PG8_SA
#undef PG8_SB
#undef PG8_STAGE
#undef PG8_LDA
#undef PG8_LDB
#undef PG8_MMA
#undef PG8_WAIT_V
#undef PG8_WAIT_L
#undef PG8_BAR
#undef PG8_SCHED
}
}
#define LAS __attribute__((address_space(3)))
typedef unsigned short bf16;
typedef short bf16x8 __attribute__((ext_vector_type(8)));
typedef short s16x4 __attribute__((ext_vector_type(4)));
typedef float f32x4 __attribute__((ext_vector_type(4)));
typedef float f32x16 __attribute__((ext_vector_type(16)));
typedef unsigned u32x4 __attribute__((ext_vector_type(4)));
typedef unsigned u32x2 __attribute__((ext_vector_type(2)));
#define MFMA32(a, b, c) __builtin_amdgcn_mfma_f32_32x32x16_bf16((a), (b), (c), 0, 0, 0)
__device__ __forceinline__ s16x4 vtr(const LAS unsigned char* p) { return __builtin_bit_cast(s16x4, __builtin_amdgcn_ds_read_tr16_b64_v4i16((LAS s16x4*)p)); }
__device__ __forceinline__ bf16x8 cat8(s16x4 lo, s16x4 hi) { return __builtin_shufflevector(lo, hi, 0, 1, 2, 3, 4, 5, 6, 7); }
__device__ __forceinline__ unsigned pkbf(float lo, float hi) { return pg8::cvt_pk_bf16(lo, hi); }
__device__ __forceinline__ float ex2(float x) { return __builtin_amdgcn_exp2f(x); }
__device__ __forceinline__ float lg2(float x) { return __builtin_amdgcn_logf(x); }

#define XB_TMO      128
#define XB_XCNT(j)  (256  + 64 * (j))
#define XB_XSUB(j)  (1280 + 64 * (j))
#define XB_XGEN(j)  (2304 + 64 * (j))
#define XB_TOP      3328
#define XB_TOPGEN   3392
#define XCD_BAR_WORDS 3456
#define XB_SPIN_CAP (1u << 18)

__device__ __forceinline__ unsigned xb_ld(unsigned* p)              { return __hip_atomic_load(p, __ATOMIC_RELAXED, __HIP_MEMORY_SCOPE_AGENT); }
__device__ __forceinline__ unsigned xb_add(unsigned* p, unsigned v) { return __hip_atomic_fetch_add(p, v, __ATOMIC_RELAXED, __HIP_MEMORY_SCOPE_AGENT); }
__device__ __forceinline__ unsigned xb_xcc_id() { return (unsigned)__builtin_amdgcn_s_getreg((3 << 11) | 20) & 0xFu; }
#define XB_SPIN(cond, bar) do { unsigned _sp = 0; while (cond) { __builtin_amdgcn_s_sleep(1); \
    if ((++_sp & 255u) == 0u) { if (xb_ld(&(bar)[XB_TMO])) break; if (_sp > XB_SPIN_CAP) { atomicAdd(&(bar)[XB_TMO], 1u); break; } } } } while (0)

struct XcdBarrier {
    unsigned* bar; unsigned x;
    volatile LAS unsigned* st;
};

__device__ __forceinline__ XcdBarrier xcd_barrier_post(unsigned* bar, volatile LAS unsigned* st) {
    XcdBarrier b; b.bar = bar; b.x = xb_xcc_id(); b.st = st;
    if (threadIdx.x == 0) (void)xb_add(&bar[XB_XCNT(b.x)], 1u);
    return b;
}
__device__ __forceinline__ void xcd_barrier_complete(unsigned* bar, unsigned x, unsigned& nloc, unsigned& nx) {
    const unsigned G = gridDim.x * gridDim.y * gridDim.z;
    unsigned sum, cnt, mine, sp = 0u;
    for (;;) {
        sum = 0u; cnt = 0u; mine = 0u;
#pragma unroll
        for (unsigned j = 0; j < 16; ++j) { const unsigned c = xb_ld(&bar[XB_XCNT(j)]); sum += c; cnt += (c > 0u) ? 1u : 0u; mine = (j == x) ? c : mine; }
        if (sum == G) break;
        __builtin_amdgcn_s_sleep(1);
        if ((++sp & 255u) == 0u) { if (xb_ld(&bar[XB_TMO])) break; if (sp > XB_SPIN_CAP) { atomicAdd(&bar[XB_TMO], 1u); break; } }
    }
    nloc = mine > 0u ? mine : 1u; nx = cnt > 0u ? cnt : 1u;
}

__device__ __forceinline__ void xcd_barrier(const XcdBarrier& b) {
    asm volatile("s_waitcnt vmcnt(0)" ::: "memory");
    __syncthreads();
    if (threadIdx.x == 0) {
        unsigned* bar = b.bar;
        __builtin_amdgcn_s_waitcnt(0);
        unsigned nloc = b.st[0], nx = b.st[1];
        if (nloc == 0u) { xcd_barrier_complete(bar, b.x, nloc, nx); b.st[0] = nloc; b.st[1] = nx; }
        const unsigned old = xb_add(&bar[XB_XSUB(b.x)], 1u);
        const unsigned gen = old / nloc;
        if (old + 1u == (gen + 1u) * nloc) {
            __builtin_amdgcn_fence(__ATOMIC_RELEASE, "agent");
            asm volatile("s_waitcnt vmcnt(0)" ::: "memory");
            const unsigned og = xb_add(&bar[XB_TOP], 1u);
            const unsigned tg = og / nx;
            if (og + 1u == (tg + 1u) * nx) xb_add(&bar[XB_TOPGEN], 1u);
            else XB_SPIN(xb_ld(&bar[XB_TOPGEN]) == tg, bar);
            __builtin_amdgcn_fence(__ATOMIC_ACQUIRE, "agent");
            xb_add(&bar[XB_XGEN(b.x)], 1u);
            asm volatile("s_waitcnt vmcnt(0)" ::: "memory");
        } else {
            XB_SPIN(xb_ld(&bar[XB_XGEN(b.x)]) == gen, bar);
            __builtin_amdgcn_fence(__ATOMIC_ACQUIRE, "agent");
            asm volatile("s_waitcnt vmcnt(0)" ::: "memory");
        }
    }
    __syncthreads();
}


constexpr int BATCH = 8, SEQ = 8192, DM = 1024, MTOK = BATCH * SEQ, DFF = 2816;
constexpr int NWAVES = 8, NTHR = 512, LDS_BYTES = 147456, LDS_BARW = 147440;
constexpr size_t MiB = 1u << 20;
constexpr size_t WS_WRI = 0, WS_WRO = 12 * MiB, WS_WKVQ = 16 * MiB, WS_WSO = 22 * MiB, WS_WFI0 = 24 * MiB, WS_WFI1 = 35 * MiB, WS_WFO0 = 46 * MiB, WS_WFO1 = 46 * MiB + 5632 * 1024, WS_SSQ = 57 * MiB;
constexpr size_t WS_BAR = 61 * MiB, BAR_BYTES = 131072;
constexpr size_t WS_XB = 64 * MiB, WS_STATS = 192 * MiB, WS_BIG = 224 * MiB;
constexpr size_t WS_RQ = WS_BIG, WS_RK = WS_BIG + 128 * MiB, WS_RV = WS_BIG + 256 * MiB, WS_RG = WS_BIG + 512 * MiB, WS_RY = WS_BIG;
constexpr size_t WS_HID = WS_BIG;
constexpr size_t WS_SO = WS_BIG, WS_SK = WS_BIG + 352 * MiB, WS_SV = WS_BIG + 480 * MiB, WS_SQ = WS_BIG + 608 * MiB, WS_END = WS_BIG + 768 * MiB;

__device__ __forceinline__ int opaque_tid() { int t = threadIdx.x; asm volatile("" : "+v"(t)); return t; }
__device__ __forceinline__ float wave_sum(float v) {
#pragma unroll
    for (int o = 1; o < 64; o <<= 1) v += __shfl_xor(v, o);
    return v;
}
__device__ __forceinline__ void transpose_item(const float* W, int K, int N, bf16* WT, const float* gain, int k0, int n0, int orow0, LAS float* scr, int lane) {
#pragma unroll 4
    for (int i = 0; i < 16; ++i) { const int kk = 4 * i + (lane >> 4); f32x4 w = *(const f32x4*)(W + (size_t)(k0 + kk) * N + n0 + 4 * (lane & 15)); if (gain) w = w * gain[k0 + kk];
        LAS float* d = scr + kk * 65 + 4 * (lane & 15); d[0] = w[0]; d[1] = w[1]; d[2] = w[2]; d[3] = w[3]; }
    asm volatile("s_waitcnt lgkmcnt(0)" ::: "memory");
#pragma unroll
    for (int j = 0; j < 8; ++j) { const int p = lane + 64 * j, n = p >> 3, c = p & 7; const LAS float* q = scr + (8 * c) * 65 + n;
        u32x4 o; o.x = pkbf(q[0 * 65], q[1 * 65]); o.y = pkbf(q[2 * 65], q[3 * 65]); o.z = pkbf(q[4 * 65], q[5 * 65]); o.w = pkbf(q[6 * 65], q[7 * 65]);
        *(u32x4*)(WT + (size_t)(orow0 + n) * K + k0 + 8 * c) = o; }
    asm volatile("s_waitcnt lgkmcnt(0)" ::: "memory");
}
__device__ __forceinline__ bool tr_matrix(int& r, const float* W, int K, int N, bf16* WT, const float* gain, int row_off, bool ffn, LAS float* scr, int lane) {
    const int nblk = N / 64, items = (K / 64) * nblk;
    if (r >= items) { r -= items; return false; }
    const int kb = r / nblk, nb = r % nblk, n0 = 64 * nb; int orow0 = row_off + n0;
    if (ffn) { const int j = n0 < DFF ? n0 : n0 - DFF; orow0 = 256 * (j >> 7) + (j & 127) + (n0 < DFF ? 0 : 128); }
    transpose_item(W, K, N, WT, gain, 64 * kb, n0, orow0, scr, lane);
    return true;
}
struct Args { const float* in[13]; float* out; unsigned char* ws; int ph_lo, ph_hi; };

__device__ __forceinline__ void prologue(const Args& a, LAS unsigned char* lds, int G, int bid) {
    const int tid = opaque_tid(), lane = tid & 63, wave = __builtin_amdgcn_readfirstlane(tid >> 6), gw = bid * NWAVES + wave, NGW = G * NWAVES;
    LAS float* scr = (LAS float*)(lds + wave * 16640);
    unsigned char* ws = a.ws;
    constexpr int NITEMS = 1536 + 512 + 512 + 256 + 256 + 2 * 1408 + 2 * 704;
    for (int it = gw; it < NITEMS; it += NGW) {
        int r = it;
        if (tr_matrix(r, a.in[2], 1024, 6144, (bf16*)(ws + WS_WRI), a.in[1], 0, false, scr, lane)) continue;
        if (tr_matrix(r, a.in[4], 2048, 1024, (bf16*)(ws + WS_WRO), nullptr, 0, false, scr, lane)) continue;
        if (tr_matrix(r, a.in[6], 1024, 2048, (bf16*)(ws + WS_WKVQ), a.in[5], 0, false, scr, lane)) continue;
        if (tr_matrix(r, a.in[7], 1024, 1024, (bf16*)(ws + WS_WKVQ), a.in[1] + 1024, 2048, false, scr, lane)) continue;
        if (tr_matrix(r, a.in[8], 1024, 1024, (bf16*)(ws + WS_WSO), nullptr, 0, false, scr, lane)) continue;
        if (tr_matrix(r, a.in[10], 1024, 5632, (bf16*)(ws + WS_WFI0), a.in[9], 0, true, scr, lane)) continue;
        if (tr_matrix(r, a.in[10] + (size_t)1024 * 5632, 1024, 5632, (bf16*)(ws + WS_WFI1), a.in[9] + 1024, 0, true, scr, lane)) continue;
        if (tr_matrix(r, a.in[11], 2816, 1024, (bf16*)(ws + WS_WFO0), nullptr, 0, false, scr, lane)) continue;
        tr_matrix(r, a.in[11] + (size_t)2816 * 1024, 2816, 1024, (bf16*)(ws + WS_WFO1), nullptr, 0, false, scr, lane);
    }
    const float* x = a.in[0]; bf16* xb = (bf16*)(ws + WS_XB);
    for (int m = gw; m < MTOK; m += NGW) {
        const f32x4* xr = (const f32x4*)(x + (size_t)m * DM) + lane; u32x2* o8 = (u32x2*)(xb + (size_t)m * DM) + lane; float s = 0.f; f32x4 v[4];
#pragma unroll
        for (int j = 0; j < 4; ++j) { v[j] = xr[64 * j]; s += (v[j][0] * v[j][0] + v[j][1] * v[j][1]) + (v[j][2] * v[j][2] + v[j][3] * v[j][3]); }
        const float r = 1.0f / sqrtf(wave_sum(s) * (1.0f / 1024.0f) + 1e-6f);
#pragma unroll
        for (int j = 0; j < 4; ++j) { u32x2 o; o.x = pkbf(v[j][0] * r, v[j][1] * r); o.y = pkbf(v[j][2] * r, v[j][3] * r); o8[64 * j] = o; }
    }
}

__device__ __forceinline__ void ret_scores_phase(LAS unsigned char* lds, const bf16* RQ, const bf16* RK, unsigned char* PB, int G, int bid) {
    const int tid = opaque_tid(), lane = tid & 63, w = __builtin_amdgcn_readfirstlane(tid >> 6), r32 = lane & 31, hh = lane >> 5;
    LAS unsigned char* KS = lds;
    const unsigned goff = (unsigned)(tid >> 5) * 2048u + (unsigned)(tid & 31) * 16u, loff = (unsigned)(tid >> 5) * 528u + (unsigned)(tid & 31) * 16u, roff = (unsigned)r32 * 528u + 16u * hh;
    u32x4 kpre[8];
    int it = bid;
    if (it < 2048) { const int bh_ = it >> 6, c = it & 63; const size_t go = (((size_t)(bh_ >> 2) * SEQ + c * 128) * 1024 + (bh_ & 3) * 256) * 2;
#pragma unroll
        for (int i = 0; i < 8; ++i) kpre[i] = *(const u32x4*)((const char*)RK + go + (size_t)(16 * i) * 2048 + goff); }
    for (; it < 2048; it += G) {
        __syncthreads();
#pragma unroll
        for (int i = 0; i < 8; ++i) *(LAS u32x4*)(KS + loff + i * (16 * 528)) = kpre[i];
        __syncthreads();
        if (it + G < 2048) { const int i2 = it + G, bh_ = i2 >> 6, c = i2 & 63; const size_t go = (((size_t)(bh_ >> 2) * SEQ + c * 128) * 1024 + (bh_ & 3) * 256) * 2;
#pragma unroll
            for (int i = 0; i < 8; ++i) kpre[i] = *(const u32x4*)((const char*)RK + go + (size_t)(16 * i) * 2048 + goff); }
        for (int tix = w; tix < 10; tix += 8) {
            const int qi = tix < 1 ? 0 : (tix < 3 ? 1 : (tix < 6 ? 2 : 3)), kj = tix - (qi * (qi + 1)) / 2;
            const char* qa = (const char*)RQ + ((size_t)(it * 4 + qi) * 16) * 1024 + lane * 16; const LAS unsigned char* ka = KS + kj * (32 * 528) + roff;
            bf16x8 qb[16];
#pragma unroll
            for (int t = 0; t < 16; ++t) qb[t] = *(const bf16x8*)(qa + t * 1024);
            f32x16 s0, s1;
#pragma unroll
            for (int i = 0; i < 16; ++i) { s0[i] = 0.f; s1[i] = 0.f; }
#pragma unroll
            for (int t = 0; t < 16; t += 2) {
                const bf16x8 a0 = *(const LAS bf16x8*)(ka + 32 * t), a1 = *(const LAS bf16x8*)(ka + 32 * t + 32);
                s0 = MFMA32(a0, qb[t], s0); s1 = MFMA32(a1, qb[t + 1], s1); }
#pragma unroll
            for (int i = 0; i < 16; ++i) { float p = s0[i] + s1[i]; if (kj == qi && (8 * (i >> 2) + 4 * hh + (i & 3)) > r32) p = 0.f; s0[i] = p; }
            u32x4 p0, p1;
#pragma unroll
            for (int e = 0; e < 4; ++e) { p0[e] = pkbf(s0[2 * e], s0[2 * e + 1]); p1[e] = pkbf(s0[8 + 2 * e], s0[8 + 2 * e + 1]); }
            unsigned char* pt = PB + ((size_t)it * 10 + tix) * 2048 + lane * 16;
            *(u32x4*)pt = p0; *(u32x4*)(pt + 1024) = p1;
        }
    }
    __syncthreads();
}
constexpr int R_KL = 0, R_VL = 67584, R_SL = R_VL + 18432;
template <bool owave> __device__ __forceinline__ void retention_role(LAS unsigned char* lds, const bf16* RQ, const bf16* RK, bf16* RV, const unsigned char* PB, float* stats, int G, int bid, int tid) {
    const int lane = tid & 63, w = __builtin_amdgcn_readfirstlane(tid >> 6), r32 = lane & 31, hh = lane >> 5, q4 = (lane & 15) >> 2, p4 = lane & 3, gsel = (lane >> 4) & 1;
    LAS unsigned char* KL = lds + R_KL; LAS unsigned char* VL = lds + R_VL; LAS unsigned char* SL = lds + R_SL;
    const int qi = w & 3, sw = w & 3, tbase = (qi * (qi + 1)) / 2;
    const LAS unsigned char* pv_base = VL + (4 * hh + q4) * 144 + (16 * gsel + 4 * p4) * 2;
    const LAS unsigned char* ktr_base = KL + (8 * hh + q4) * 528 + (64 * sw + 16 * gsel + 4 * p4) * 2;
    const LAS unsigned char* vtr_base = VL + (8 * hh + q4) * 144 + (16 * gsel + 4 * p4) * 2;
    const unsigned koff = (unsigned)(tid >> 5) * 2048u + (unsigned)(tid & 31) * 16u, voff = (unsigned)(tid >> 3) * 4096u + (unsigned)(tid & 7) * 16u;
    const unsigned qoff = (unsigned)(32 * qi + r32) * 2048u + 16u * hh, ooff = (unsigned)(32 * qi + r32) * 4096u + (unsigned)(4 * hh) * 2u, soff = (unsigned)(32 * qi + r32) * 512u;
    const unsigned poff = (unsigned)tbase * 2048u + (unsigned)lane * 16u;
    for (int it = bid; it < 256; it += G) {
        const int bh_ = (it & 7) * 4 + (it >> 6), vs = (it >> 3) & 7, b = bh_ >> 2, h = bh_ & 3;
        const float cdec = ex2(128.0f * log2f(1.0f - exp2f(-5.0f - (float)h)));
        const char* Qp = (const char*)RQ + ((size_t)(bh_ * 64) * 4 + qi) * 16 * 1024 + lane * 16;
        const char* Kp = (const char*)(RK + (size_t)b * SEQ * 1024 + h * 256);
        char* Vp = (char*)(RV + (size_t)b * SEQ * 2048 + h * 512 + vs * 64);
        const unsigned char* Pp = PB + (size_t)bh_ * 64 * 10 * 2048;
        char* stp = (char*)(stats + ((size_t)b * SEQ * 4 + h) * 32 + (vs * 2) * 2);
        f32x16 st[2][2];
#pragma unroll
        for (int i = 0; i < 16; ++i) { st[0][0][i] = 0.f; st[0][1][i] = 0.f; st[1][0][i] = 0.f; st[1][1][i] = 0.f; }
        u32x4 kpre[8], vpre[2], pp[4][2]; bf16x8 qf[16];
#pragma unroll
        for (int i = 0; i < 8; ++i) kpre[i] = *(const u32x4*)(Kp + (size_t)(16 * i) * 2048 + koff);
#pragma unroll
        for (int i = 0; i < 2; ++i) vpre[i] = *(const u32x4*)(Vp + (size_t)(64 * i) * 4096 + voff);
        if (owave) {
#pragma unroll
            for (int t = 0; t < 16; ++t) qf[t] = *(const bf16x8*)(Qp + t * 1024);
#pragma unroll
            for (int kj = 0; kj < 4; ++kj) if (kj <= qi) { pp[kj][0] = *(const u32x4*)(Pp + kj * 2048 + poff); pp[kj][1] = *(const u32x4*)(Pp + kj * 2048 + 1024 + poff); }
        }
        for (int c = 0; c < 64; ++c) {
            __syncthreads();
#pragma unroll
            for (int i = 0; i < 8; ++i) *(LAS u32x4*)(KL + (tid >> 5) * 528 + (tid & 31) * 16 + i * (16 * 528)) = kpre[i];
#pragma unroll
            for (int i = 0; i < 2; ++i) *(LAS u32x4*)(VL + (tid >> 3) * 144 + (tid & 7) * 16 + i * (64 * 144)) = vpre[i];
            if (!owave) {
#pragma unroll
                for (int dt = 0; dt < 2; ++dt)
#pragma unroll
                    for (int vt = 0; vt < 2; ++vt)
#pragma unroll
                        for (int k = 0; k < 4; ++k) { u32x2 a0; a0.x = pkbf(st[dt][vt][4 * k], st[dt][vt][4 * k + 1]); a0.y = pkbf(st[dt][vt][4 * k + 2], st[dt][vt][4 * k + 3]);
                            *(LAS u32x2*)(SL + (32 * vt + r32) * 528 + (64 * sw + 32 * dt + 4 * hh) * 2 + 16 * k) = a0; }
            }
            __syncthreads();
            if (c + 1 < 64) {
                const char* kc = Kp + (size_t)(c + 1) * (128 * 2048); const char* vc = Vp + (size_t)(c + 1) * (128 * 4096);
#pragma unroll
                for (int i = 0; i < 8; ++i) kpre[i] = *(const u32x4*)(kc + (size_t)(16 * i) * 2048 + koff);
#pragma unroll
                for (int i = 0; i < 2; ++i) vpre[i] = *(const u32x4*)(vc + (size_t)(64 * i) * 4096 + voff);
            }
            __builtin_amdgcn_sched_barrier(0);
            if (owave) {
                f32x16 o0, o1;
#pragma unroll
                for (int i = 0; i < 16; ++i) { o0[i] = 0.f; o1[i] = 0.f; }
                { const LAS unsigned char* sa = SL + r32 * 528 + 16 * hh;
                  bf16x8 ra[4], rb[4];
#pragma unroll
                  for (int t = 0; t < 4; ++t) { ra[t] = *(const LAS bf16x8*)(sa + 32 * t); rb[t] = *(const LAS bf16x8*)(sa + 32 * 528 + 32 * t); }
                  __builtin_amdgcn_sched_group_barrier(0x100, 8, 0);
#pragma unroll
                  for (int t = 0; t < 16; ++t) {
                      o0 = MFMA32(ra[t & 3], qf[t], o0); o1 = MFMA32(rb[t & 3], qf[t], o1);
                      __builtin_amdgcn_sched_group_barrier(0x8, 2, 0);
                      if (t + 4 < 16) { ra[t & 3] = *(const LAS bf16x8*)(sa + 32 * (t + 4)); rb[t & 3] = *(const LAS bf16x8*)(sa + 32 * 528 + 32 * (t + 4)); __builtin_amdgcn_sched_group_barrier(0x100, 2, 0); }
                  } }
#pragma unroll
                for (int i = 0; i < 16; ++i) { o0[i] *= cdec; o1[i] *= cdec; }
                if (c + 1 < 64) {
                    const char* qc = Qp + (size_t)(c + 1) * (4 * 16 * 1024);
#pragma unroll
                    for (int t = 0; t < 16; ++t) qf[t] = *(const bf16x8*)(qc + t * 1024);
                }
                __builtin_amdgcn_sched_barrier(0);
#pragma unroll
                for (int kj = 0; kj < 4; ++kj) if (kj <= qi) {
                    const LAS unsigned char* vb = pv_base + kj * (32 * 144);
                    const s16x4 v0 = vtr(vb), v1 = vtr(vb + 8 * 144), v2 = vtr(vb + 64), v3 = vtr(vb + 8 * 144 + 64), v4 = vtr(vb + 16 * 144), v5 = vtr(vb + 24 * 144), v6 = vtr(vb + 16 * 144 + 64), v7 = vtr(vb + 24 * 144 + 64);
                    __builtin_amdgcn_sched_group_barrier(0x100, 8, 2);
                    o0 = MFMA32(cat8(v0, v1), __builtin_bit_cast(bf16x8, pp[kj][0]), o0);
                    o1 = MFMA32(cat8(v2, v3), __builtin_bit_cast(bf16x8, pp[kj][0]), o1);
                    o0 = MFMA32(cat8(v4, v5), __builtin_bit_cast(bf16x8, pp[kj][1]), o0);
                    o1 = MFMA32(cat8(v6, v7), __builtin_bit_cast(bf16x8, pp[kj][1]), o1);
                    __builtin_amdgcn_sched_group_barrier(0x8, 4, 2);
                }
                if (c + 1 < 64) {
                    const unsigned char* pc = Pp + (size_t)(c + 1) * (10 * 2048);
#pragma unroll
                    for (int kj = 0; kj < 4; ++kj) if (kj <= qi) { pp[kj][0] = *(const u32x4*)(pc + kj * 2048 + poff); pp[kj][1] = *(const u32x4*)(pc + kj * 2048 + 1024 + poff); }
                }
                __builtin_amdgcn_sched_barrier(0);
                { char* oc = Vp + (size_t)c * (128 * 4096); float s1 = 0.f, s2 = 0.f, t1 = 0.f, t2 = 0.f;
#pragma unroll
                  for (int k = 0; k < 4; ++k) { u32x2 ov; ov.x = pkbf(o0[4 * k], o0[4 * k + 1]); ov.y = pkbf(o0[4 * k + 2], o0[4 * k + 3]); *(u32x2*)(oc + 16 * k + ooff) = ov;
                      u32x2 ow; ow.x = pkbf(o1[4 * k], o1[4 * k + 1]); ow.y = pkbf(o1[4 * k + 2], o1[4 * k + 3]); *(u32x2*)(oc + 64 + 16 * k + ooff) = ow;
#pragma unroll
                      for (int r = 0; r < 4; ++r) { s1 += o0[4 * k + r]; s2 += o0[4 * k + r] * o0[4 * k + r]; t1 += o1[4 * k + r]; t2 += o1[4 * k + r] * o1[4 * k + r]; } }
                  s1 += __shfl_xor(s1, 32); s2 += __shfl_xor(s2, 32); t1 += __shfl_xor(t1, 32); t2 += __shfl_xor(t2, 32);
                  if (hh == 0) { f32x4 sv; sv[0] = s1; sv[1] = s2; sv[2] = t1; sv[3] = t2; *(f32x4*)(stp + (size_t)c * (128 * 512) + soff) = sv; } }
            } else if (c + 1 < 64) {
#pragma unroll
                for (int i = 0; i < 16; ++i) { st[0][0][i] *= cdec; st[0][1][i] *= cdec; st[1][0][i] *= cdec; st[1][1][i] *= cdec; }
                {
                    s16x4 fa[2][4], fb[2][4];
#define ST_LOAD(buf, t) do { fa[buf][0] = vtr(ktr_base + (16 * (t)) * 528); fa[buf][1] = vtr(ktr_base + (16 * (t) + 4) * 528); fa[buf][2] = vtr(ktr_base + (16 * (t)) * 528 + 64); fa[buf][3] = vtr(ktr_base + (16 * (t) + 4) * 528 + 64); \
                             fb[buf][0] = vtr(vtr_base + (16 * (t)) * 144); fb[buf][1] = vtr(vtr_base + (16 * (t) + 4) * 144); fb[buf][2] = vtr(vtr_base + (16 * (t)) * 144 + 64); fb[buf][3] = vtr(vtr_base + (16 * (t) + 4) * 144 + 64); } while (0)
                    ST_LOAD(0, 0); __builtin_amdgcn_sched_group_barrier(0x100, 8, 1);
#pragma unroll
                    for (int t = 0; t < 8; ++t) {
                        if (t + 1 < 8) { ST_LOAD((t + 1) & 1, t + 1); __builtin_amdgcn_sched_group_barrier(0x100, 8, 1); }
                        const bf16x8 a0 = cat8(fa[t & 1][0], fa[t & 1][1]), a1 = cat8(fa[t & 1][2], fa[t & 1][3]), b0 = cat8(fb[t & 1][0], fb[t & 1][1]), b1 = cat8(fb[t & 1][2], fb[t & 1][3]);
                        st[0][0] = MFMA32(a0, b0, st[0][0]); st[0][1] = MFMA32(a0, b1, st[0][1]); st[1][0] = MFMA32(a1, b0, st[1][0]); st[1][1] = MFMA32(a1, b1, st[1][1]);
                        __builtin_amdgcn_sched_group_barrier(0x8, 4, 1);
                    }
#undef ST_LOAD
                }
            }
        }
        __syncthreads();
    }
}

__device__ __forceinline__ void retention_phase(LAS unsigned char* lds, const bf16* RQ, const bf16* RK, bf16* RV, const unsigned char* PB, float* stats, unsigned* dbg, int G, int bid) {
    const int tid = opaque_tid();
    if (__builtin_amdgcn_readfirstlane(tid >> 6) < 4) retention_role<true>(lds, RQ, RK, RV, PB, stats, G, bid, tid);
    else retention_role<false>(lds, RQ, RK, RV, PB, stats, G, bid, tid);
}

__device__ __forceinline__ void gngate_phase(const bf16* RV, const bf16* RG, bf16* RY, const float* stats, const float* gng, int G, int bid) {
    const int tid = opaque_tid(), lane = tid & 63, gw = bid * NWAVES + __builtin_amdgcn_readfirstlane(tid >> 6), NGW = G * NWAVES;
    for (int idx = gw; idx < MTOK * 4; idx += NGW) {
        const int h = idx & 3; const size_t off = (size_t)(idx >> 2) * 2048 + h * 512 + 8 * lane;
        const u32x4 ov = *(const u32x4*)(RV + off), gv = *(const u32x4*)(RG + off);
        const f32x4 g0 = *(const f32x4*)(gng + h * 512 + 8 * lane), g1 = *(const f32x4*)(gng + h * 512 + 8 * lane + 4);
        f32x2v sv = {0.f, 0.f}; if (lane < 16) sv = *(const f32x2v*)(stats + ((size_t)idx * 16 + lane) * 2);
        float s1 = sv.x, s2 = sv.y;
#pragma unroll
        for (int o = 1; o < 16; o <<= 1) { s1 += __shfl_xor(s1, o); s2 += __shfl_xor(s2, o); }
        s1 = __shfl(s1, 0); s2 = __shfl(s2, 0);
        const float mu = s1 * (1.0f / 512.0f), var = fmaxf(s2 * (1.0f / 512.0f) - mu * mu, 0.f), rstd = __builtin_amdgcn_rsqf(var + 1e-5f);
        float y[8];
#pragma unroll
        for (int e = 0; e < 4; ++e) {
            const float oa = __uint_as_float(ov[e] << 16), ob = __uint_as_float(ov[e] & 0xffff0000u), ga = __uint_as_float(gv[e] << 16), gb = __uint_as_float(gv[e] & 0xffff0000u);
            const float wa = e < 2 ? g0[2 * e] : g1[2 * e - 4], wb = e < 2 ? g0[2 * e + 1] : g1[2 * e - 3];
            y[2 * e] = ga * __builtin_amdgcn_rcpf(1.0f + ex2(-1.4426950408889634f * ga)) * ((oa - mu) * rstd * wa);
            y[2 * e + 1] = gb * __builtin_amdgcn_rcpf(1.0f + ex2(-1.4426950408889634f * gb)) * ((ob - mu) * rstd * wb);
        }
        u32x4 yo; yo.x = pkbf(y[0], y[1]); yo.y = pkbf(y[2], y[3]); yo.z = pkbf(y[4], y[5]); yo.w = pkbf(y[6], y[7]);
        *(u32x4*)(RY + off) = yo;
    }
}

template <int MODE> __device__ __forceinline__ void sb_tile(f32x16& z, float& carry, int r32, int hh) {
    if (MODE == 2) {
#pragma unroll
        for (int i = 0; i < 16; ++i) z[i] = 0.f;
        return; }
    typedef float f2 __attribute__((ext_vector_type(2)));
    f2 G2[2], PG2[2], zz[2][4];
#pragma unroll
    for (int kp = 0; kp < 2; ++kp) {
        f2 ee[4], ww[4];
#pragma unroll
        for (int r = 0; r < 4; ++r) {
            f2 zv = {z[4 * kp + r], z[4 * (kp + 2) + r]};
            zv = __builtin_elementwise_min(zv, (f2){30.f, 30.f});
            ee[r].x = ex2(zv.x); ee[r].y = ex2(zv.y);
            if (MODE == 1) { if ((8 * kp + 4 * hh + r) >= r32) ee[r].x = 0.f; if ((8 * (kp + 2) + 4 * hh + r) >= r32) ee[r].y = 0.f; }
            ww[r] = ee[r] + 1.0f;
        }
        const f2 p1 = ww[0], p2 = p1 * ww[1], p3 = p2 * ww[2], pp4 = p3 * ww[3];
        f2 R; R.x = __builtin_amdgcn_rcpf(pp4.x); R.y = __builtin_amdgcn_rcpf(pp4.y);
        zz[kp][0] = ee[0] * R; zz[kp][1] = ee[1] * (p1 * R); zz[kp][2] = ee[2] * (p2 * R); zz[kp][3] = ee[3] * (p3 * R);
        G2[kp] = R;
    }
#pragma unroll
    for (int kp = 0; kp < 2; ++kp) { PG2[kp].x = __shfl_xor(G2[kp].x, 32); PG2[kp].y = __shfl_xor(G2[kp].y, 32); }
    const float B3 = G2[1].y * PG2[1].y, B2 = G2[0].y * PG2[0].y, B1 = G2[1].x * PG2[1].x, B0 = G2[0].x * PG2[0].x;
    const float t3 = carry, t2 = t3 * B3, t1 = t2 * B2, t0 = t1 * B1;
    const bool lo = hh == 0;
    f2 off0, off1;
    off0.x = t0 * (lo ? PG2[0].x : 1.f); off0.y = t2 * (lo ? PG2[0].y : 1.f); off1.x = t1 * (lo ? PG2[1].x : 1.f); off1.y = t3 * (lo ? PG2[1].y : 1.f);
#pragma unroll
    for (int r = 0; r < 4; ++r) { const f2 a0 = zz[0][r] * off0, a1 = zz[1][r] * off1; z[r] = a0.x; z[8 + r] = a0.y; z[4 + r] = a1.x; z[12 + r] = a1.y; }
    carry = t0 * B0;
}
template <int MH> __device__ __forceinline__ void sb_pair(f32x16& zH, f32x16& zL, float& carry, int r32, int hh) {
    typedef float f2 __attribute__((ext_vector_type(2)));
    f2 GH[2], GL[2], PH[2], PL[2], aH[2][4], aL[2][4];
#pragma unroll
    for (int kp = 0; kp < 2; ++kp) {
        f2 eh[4], el[4], wh[4], wl[4];
#pragma unroll
        for (int r = 0; r < 4; ++r) {
            f2 vh = {zH[4 * kp + r], zH[4 * (kp + 2) + r]}, vl = {zL[4 * kp + r], zL[4 * (kp + 2) + r]};
            vh = __builtin_elementwise_min(vh, (f2){30.f, 30.f}); vl = __builtin_elementwise_min(vl, (f2){30.f, 30.f});
            eh[r].x = ex2(vh.x); eh[r].y = ex2(vh.y); el[r].x = ex2(vl.x); el[r].y = ex2(vl.y);
            if (MH == 1) { if ((8 * kp + 4 * hh + r) >= r32) eh[r].x = 0.f; if ((8 * (kp + 2) + 4 * hh + r) >= r32) eh[r].y = 0.f; }
            wh[r] = eh[r] + 1.0f; wl[r] = el[r] + 1.0f;
        }
        const f2 h1 = wh[0], h2 = h1 * wh[1], h3 = h2 * wh[2], h4 = h3 * wh[3], l1 = wl[0], l2 = l1 * wl[1], l3 = l2 * wl[2], l4 = l3 * wl[3];
        f2 RH, RL; RH.x = __builtin_amdgcn_rcpf(h4.x); RH.y = __builtin_amdgcn_rcpf(h4.y); RL.x = __builtin_amdgcn_rcpf(l4.x); RL.y = __builtin_amdgcn_rcpf(l4.y);
        aH[kp][0] = eh[0] * RH; aH[kp][1] = eh[1] * (h1 * RH); aH[kp][2] = eh[2] * (h2 * RH); aH[kp][3] = eh[3] * (h3 * RH);
        aL[kp][0] = el[0] * RL; aL[kp][1] = el[1] * (l1 * RL); aL[kp][2] = el[2] * (l2 * RL); aL[kp][3] = el[3] * (l3 * RL);
        GH[kp] = RH; GL[kp] = RL;
    }
#pragma unroll
    for (int kp = 0; kp < 2; ++kp) { PH[kp].x = __shfl_xor(GH[kp].x, 32); PH[kp].y = __shfl_xor(GH[kp].y, 32); PL[kp].x = __shfl_xor(GL[kp].x, 32); PL[kp].y = __shfl_xor(GL[kp].y, 32); }
    const bool lo = hh == 0;
    {
        const float B3 = GH[1].y * PH[1].y, B2 = GH[0].y * PH[0].y, B1 = GH[1].x * PH[1].x, B0 = GH[0].x * PH[0].x;
        const float t3 = carry, t2 = t3 * B3, t1 = t2 * B2, t0 = t1 * B1;
        f2 off0, off1; off0.x = t0 * (lo ? PH[0].x : 1.f); off0.y = t2 * (lo ? PH[0].y : 1.f); off1.x = t1 * (lo ? PH[1].x : 1.f); off1.y = t3 * (lo ? PH[1].y : 1.f);
#pragma unroll
        for (int r = 0; r < 4; ++r) { const f2 a0 = aH[0][r] * off0, a1 = aH[1][r] * off1; zH[r] = a0.x; zH[8 + r] = a0.y; zH[4 + r] = a1.x; zH[12 + r] = a1.y; }
        carry = t0 * B0; }
    {   const float B3 = GL[1].y * PL[1].y, B2 = GL[0].y * PL[0].y, B1 = GL[1].x * PL[1].x, B0 = GL[0].x * PL[0].x;
        const float t3 = carry, t2 = t3 * B3, t1 = t2 * B2, t0 = t1 * B1;
        f2 off0, off1; off0.x = t0 * (lo ? PL[0].x : 1.f); off0.y = t2 * (lo ? PL[0].y : 1.f); off1.x = t1 * (lo ? PL[1].x : 1.f); off1.y = t3 * (lo ? PL[1].y : 1.f);
#pragma unroll
        for (int r = 0; r < 4; ++r) { const f2 a0 = aL[0][r] * off0, a1 = aL[1][r] * off1; zL[r] = a0.x; zL[8 + r] = a0.y; zL[4 + r] = a1.x; zL[12 + r] = a1.y; }
        carry = t0 * B0; }
}
__device__ __forceinline__ void sb_pv(f32x16& o0, f32x16& o1, const f32x16& z, const LAS unsigned char* vb) {
    u32x4 p0, p1;
#pragma unroll
    for (int e = 0; e < 4; ++e) { p0[e] = pkbf(z[2 * e], z[2 * e + 1]); p1[e] = pkbf(z[8 + 2 * e], z[8 + 2 * e + 1]); }
    o0 = MFMA32(cat8(vtr(vb), vtr(vb + 8 * 144)), __builtin_bit_cast(bf16x8, p0), o0);
    o1 = MFMA32(cat8(vtr(vb + 64), vtr(vb + 8 * 144 + 64)), __builtin_bit_cast(bf16x8, p0), o1);
    o0 = MFMA32(cat8(vtr(vb + 16 * 144), vtr(vb + 24 * 144)), __builtin_bit_cast(bf16x8, p1), o0);
    o1 = MFMA32(cat8(vtr(vb + 16 * 144 + 64), vtr(vb + 24 * 144 + 64)), __builtin_bit_cast(bf16x8, p1), o1);
}
constexpr int SB_WT = 14, SB_ROWS = 448, SB_KS = 0, SB_VS = SB_ROWS * 144;
static_assert(SB_WT * 32 <= SB_ROWS && SB_ROWS * 8 == 7 * 512, "the staging loop writes exactly 448 rows (7 x 16-byte pieces per thread) per image");
__device__ __forceinline__ void sb_window_load(u32x4 (&kr)[7], u32x4 (&vr)[7], const char* Kp, const char* Vp, int wlo, int nrows, int tid) {
#pragma unroll
    for (int i = 0; i < 7; ++i) { const int id = tid + 512 * i, row = id >> 3; const int rr = row < nrows ? row : 0;
        const size_t off = (size_t)(wlo * 32 + rr) * 2048 + (id & 7) * 16; kr[i] = *(const u32x4*)(Kp + off); vr[i] = *(const u32x4*)(Vp + off); }
}
__device__ __forceinline__ void sb_phase(LAS unsigned char* lds, const bf16* Kb, const bf16* Vb, const bf16* Qb, bf16* Ob, int G, int bid) {
    const int tid = opaque_tid();
    const int lane = tid & 63, w = __builtin_amdgcn_readfirstlane(tid >> 6), r32 = lane & 31, hh = lane >> 5, q4 = (lane & 15) >> 2, p4 = lane & 3, gsel = (lane >> 4) & 1;
    LAS unsigned char* KS = lds + SB_KS; LAS unsigned char* VS = lds + SB_VS;
    const LAS unsigned char* ka_base = KS + r32 * 144 + 16 * hh;
    const LAS unsigned char* pv_base = VS + (4 * hh + q4) * 144 + (16 * gsel + 4 * p4) * 2;
    const unsigned koff = (unsigned)r32 * 2048u + 16u * hh;
    u32x4 kr[7], vr[7];
    int u = bid;
    if (u < 4096) { const int bh = u >> 5, qb = u & 31, whi = 8 * qb + 7, wlo = whi - (SB_WT - 1) > 0 ? whi - (SB_WT - 1) : 0;
        sb_window_load(kr, vr, (const char*)(Kb + (size_t)(bh >> 4) * SEQ * 1024 + (bh & 15) * 64), (const char*)(Vb + (size_t)(bh >> 4) * SEQ * 1024 + (bh & 15) * 64), wlo, (whi - wlo + 1) * 32, tid); }
    for (; u < 4096; u += G) {
        const int bh = u >> 5, qb = u & 31, b = bh >> 4, h = bh & 15, qt = qb * 8 + w;
        const char* Kp = (const char*)(Kb + (size_t)b * SEQ * 1024 + h * 64); const char* Vp = (const char*)(Vb + (size_t)b * SEQ * 1024 + h * 64);
        bf16x8 qf[4];
        { const char* qp = (const char*)(Qb + (size_t)b * SEQ * 1024 + h * 64) + (size_t)qt * (32 * 2048);
#pragma unroll
          for (int t = 0; t < 4; ++t) qf[t] = *(const bf16x8*)(qp + 32 * t + koff); }
        f32x16 o0, o1;
#pragma unroll
        for (int i = 0; i < 16; ++i) { o0[i] = 0.f; o1[i] = 0.f; }
        float carry = 1.f; int nt = qt; bool done = false;
        bool extra = false;
        for (int whi = 8 * qb + 7;;) {
            const int wlo = whi - (SB_WT - 1) > 0 ? whi - (SB_WT - 1) : 0;
            __syncthreads();
#pragma unroll
            for (int i = 0; i < 7; ++i) { const int id = tid + 512 * i; *(LAS u32x4*)(KS + (id >> 3) * 144 + (id & 7) * 16) = kr[i]; *(LAS u32x4*)(VS + (id >> 3) * 144 + (id & 7) * 16) = vr[i]; }
            __syncthreads();
            if (whi == 8 * qb + 7 && u + G < 4096) {
                const int u2 = u + G, bh2 = u2 >> 5, qb2 = u2 & 31, whi2 = 8 * qb2 + 7, wlo2 = whi2 - (SB_WT - 1) > 0 ? whi2 - (SB_WT - 1) : 0;
                sb_window_load(kr, vr, (const char*)(Kb + (size_t)(bh2 >> 4) * SEQ * 1024 + (bh2 & 15) * 64), (const char*)(Vb + (size_t)(bh2 >> 4) * SEQ * 1024 + (bh2 & 15) * 64), wlo2, (whi2 - wlo2 + 1) * 32, tid);
            }
            while (!done && nt >= wlo) {
                const int tH = nt, tL = nt - 1; const bool validL = tL >= wlo;
                const LAS unsigned char* kh = ka_base + (tH - wlo) * (32 * 144); const LAS unsigned char* kl = ka_base + ((validL ? tL : tH) - wlo) * (32 * 144);
                f32x16 zH, zL;
#pragma unroll
                for (int i = 0; i < 16; ++i) { zH[i] = 0.f; zL[i] = 0.f; }
#pragma unroll
                for (int t = 0; t < 4; ++t) { zH = MFMA32(*(const LAS bf16x8*)(kh + 32 * t), qf[t], zH); zL = MFMA32(*(const LAS bf16x8*)(kl + 32 * t), qf[t], zL); }
                if (validL) { if (tH == qt) sb_pair<1>(zH, zL, carry, r32, hh); else sb_pair<0>(zH, zL, carry, r32, hh); }
                else { if (tH == qt) sb_tile<1>(zH, carry, r32, hh); else sb_tile<0>(zH, carry, r32, hh); sb_tile<2>(zL, carry, r32, hh); }
                sb_pv(o0, o1, zH, pv_base + (tH - wlo) * (32 * 144));
                sb_pv(o0, o1, zL, pv_base + ((validL ? tL : tH) - wlo) * (32 * 144));
                nt -= validL ? 2 : 1;
                if (__builtin_amdgcn_ballot_w64(carry != 0.f) == 0ull || nt < 0) done = true;
            }
            if (nt < 0) done = true;
            if (!__syncthreads_or(done ? 0 : 1)) break;
            whi = wlo - 1;
            { const int wlo3 = whi - (SB_WT - 1) > 0 ? whi - (SB_WT - 1) : 0;
              extra = true; if (whi >= 0) sb_window_load(kr, vr, Kp, Vp, wlo3, (whi - wlo3 + 1) * 32, tid); }
        }
        if (extra && u + G < 4096) { const int u2 = u + G, bh2 = u2 >> 5, qb2 = u2 & 31, whi2 = 8 * qb2 + 7, wlo2 = whi2 - (SB_WT - 1) > 0 ? whi2 - (SB_WT - 1) : 0;
            sb_window_load(kr, vr, (const char*)(Kb + (size_t)(bh2 >> 4) * SEQ * 1024 + (bh2 & 15) * 64), (const char*)(Vb + (size_t)(bh2 >> 4) * SEQ * 1024 + (bh2 & 15) * 64), wlo2, (whi2 - wlo2 + 1) * 32, tid); }
        char* op = (char*)(Ob + (size_t)b * SEQ * 1024 + h * 64) + (size_t)qt * (32 * 2048) + (unsigned)r32 * 2048u + 8u * hh;
#pragma unroll
        for (int k = 0; k < 4; ++k) { u32x2 a0, a1; a0.x = pkbf(o0[4 * k], o0[4 * k + 1]); a0.y = pkbf(o0[4 * k + 2], o0[4 * k + 3]); a1.x = pkbf(o1[4 * k], o1[4 * k + 1]); a1.y = pkbf(o1[4 * k + 2], o1[4 * k + 3]);
            *(u32x2*)(op + 16 * k) = a0; *(u32x2*)(op + 64 + 16 * k) = a1; }
    }
}

__device__ __forceinline__ void final_norm_phase(float* out, const float* ssq, const float* g, int G, int bid) {
    const int tid = opaque_tid(), lane = tid & 63, gw = bid * NWAVES + __builtin_amdgcn_readfirstlane(tid >> 6), NGW = G * NWAVES;
    for (int m = gw; m < MTOK; m += NGW) {
        float s = lane < 16 ? ssq[(size_t)m * 16 + lane] : 0.f;
#pragma unroll
        for (int o = 1; o < 16; o <<= 1) s += __shfl_xor(s, o);
        s = __shfl(s, 0);
        const float rinv = 1.0f / sqrtf(s * (1.0f / 1024.0f) + 1e-6f);
        f32x4* xr = (f32x4*)(out + (size_t)m * DM) + lane; const f32x4* gr = (const f32x4*)g + lane;
#pragma unroll
        for (int j = 0; j < 4; ++j) xr[64 * j] = xr[64 * j] * rinv * gr[64 * j];
    }
}

__global__ void __launch_bounds__(NTHR, 2) yoco_fwd(Args a) {
    extern __shared__ __attribute__((aligned(16))) unsigned char lds_raw[];
    LAS unsigned char* lds = (LAS unsigned char*)lds_raw;
    cg::grid_group grid = cg::this_grid();
    const int G = gridDim.x, bid = blockIdx.x;
    unsigned char* ws = a.ws;
    bf16* XB = (bf16*)(ws + WS_XB); float* SSQ = (float*)(ws + WS_SSQ); float* out = a.out;
    const int lo = a.ph_lo, hi = a.ph_hi;
    volatile LAS unsigned* bst = (volatile LAS unsigned*)(lds + LDS_BARW);
    if (threadIdx.x < 2) bst[threadIdx.x] = 0u;
    __syncthreads();
    const XcdBarrier bar = xcd_barrier_post((unsigned*)(ws + WS_BAR), bst);
#ifndef PHM
#define PHM 0x1fff
#endif
#define IN(k) (((PHM >> (k)) & 1) && lo <= (k) && (k) < hi)
#define SEAM(k) do { if (lo <= (k) && (k) + 1 < hi) xcd_barrier(bar); } while (0)
#define GEMM_RESID(ph, AOFF, BOFF, KK, BASE, WANT) if (IN(ph)) { pg8::Gemm g{(const bf16*)(ws + (AOFF)), (const bf16*)(ws + (BOFF)), MTOK, 1024, (KK)}; pg8::StaticOrder S; S.init(MTOK, 1024, G, bid); \
        pg8::EpiNorm<false> E{(BASE), out, XB, nullptr, (float*)(ws + WS_STATS), (unsigned*)(ws + WS_BAR + 65536), (WANT), (LAS float*)(lds + 131072), (LAS float*)(lds + 131072 + 4096)}; \
        pg8::gemm_phase<pg8::EpiNorm<false>, pg8::StaticOrder, true, true>(lds, g, S, E); }
#define GEMM_FFNIN(ph, BOFF) if (IN(ph)) { pg8::Gemm g{XB, (const bf16*)(ws + (BOFF)), MTOK, 2 * DFF, 1024}; pg8::StaticOrder S; S.init(MTOK, 2 * DFF, G, bid); \
        pg8::EpiSwiGLU E{(bf16*)(ws + WS_HID), SSQ}; pg8::gemm_phase<pg8::EpiSwiGLU, pg8::StaticOrder, true, true>(lds, g, S, E); }
    if (hi > 64) grid.sync();
    if (IN(0)) prologue(a, lds, G, bid);
    SEAM(0);
#define PHASE1 if (IN(1)) { pg8::Gemm g{XB, (const bf16*)(ws + WS_WRI), MTOK, 6144, 1024}; pg8::StaticOrder S; S.init(MTOK, 6144, G, bid); \
        pg8::EpiProj E{(bf16*)(ws + WS_RQ), (bf16*)(ws + WS_RV), SSQ}; pg8::gemm_phase<pg8::EpiProj, pg8::StaticOrder, true, true>(lds, g, S, E); }
#define PHASE2 if (IN(2)) { ret_scores_phase(lds, (const bf16*)(ws + WS_RQ), (const bf16*)(ws + WS_RK), (unsigned char*)out, G, bid); xcd_barrier(bar); \
        retention_phase(lds, (const bf16*)(ws + WS_RQ), (const bf16*)(ws + WS_RK), (bf16*)(ws + WS_RV), (const unsigned char*)out, (float*)(ws + WS_STATS), (unsigned*)(ws + WS_BAR) + 3600, G, bid); }
    PHASE1
    SEAM(1);
    PHASE2
    SEAM(2);
    if (IN(3)) gngate_phase((const bf16*)(ws + WS_RV), (const bf16*)(ws + WS_RG), (bf16*)(ws + WS_RY), (const float*)(ws + WS_STATS), a.in[3], G, bid);
    SEAM(3);
    GEMM_RESID(4, WS_RY, WS_WRO, 2048, a.in[0], 16u)
    SEAM(4);
    GEMM_FFNIN(5, WS_WFI0)
    SEAM(5);
    GEMM_RESID(6, WS_HID, WS_WFO0, DFF, (const float*)out, 32u)
    SEAM(6);
    if (IN(7)) { pg8::Gemm g{XB, (const bf16*)(ws + WS_WKVQ), MTOK, 3072, 1024}; pg8::StaticOrder S; S.init(MTOK, 3072, G, bid);
        pg8::EpiKVQ E{(bf16*)(ws + WS_SK), SSQ, 0.125f * 1.4426950408889634f}; pg8::gemm_phase<pg8::EpiKVQ, pg8::StaticOrder, true, true>(lds, g, S, E); }
    SEAM(7);
    if (IN(8)) sb_phase(lds, (const bf16*)(ws + WS_SK), (const bf16*)(ws + WS_SV), (const bf16*)(ws + WS_SQ), (bf16*)(ws + WS_SO), G, bid);
    SEAM(8);
    GEMM_RESID(9, WS_SO, WS_WSO, 1024, (const float*)out, 48u)
    SEAM(9);
    GEMM_FFNIN(10, WS_WFI1)
    SEAM(10);
    if (IN(11)) { pg8::Gemm g{(const bf16*)(ws + WS_HID), (const bf16*)(ws + WS_WFO1), MTOK, 1024, DFF}; pg8::StaticOrder S; S.init(MTOK, 1024, G, bid);
        pg8::EpiNorm<true> E{(const float*)out, out, nullptr, a.in[12], (float*)(ws + WS_STATS), (unsigned*)(ws + WS_BAR + 65536), 64u, (LAS float*)(lds + 131072), (LAS float*)(lds + 131072 + 4096)};
        pg8::gemm_phase<pg8::EpiNorm<true>, pg8::StaticOrder, true, true>(lds, g, S, E); }
}

extern "C" void kernel_launch(void* const* d_in, const int* in_sizes, int n_in, void* d_out, int out_size, void* d_ws, size_t ws_size, hipStream_t stream) {
    static int grid = 0;
    if (grid == 0) {
        if (n_in != 13 || out_size != MTOK * DM || ws_size < WS_END) { fprintf(stderr, "kernel_launch: unexpected shapes / workspace (%d inputs, out %d, ws %zu)\n", n_in, out_size, ws_size); grid = -1; return; }
        int dev = 0, cus = 0, per_cu = 0;
        (void)hipGetDevice(&dev); (void)hipDeviceGetAttribute(&cus, hipDeviceAttributeMultiprocessorCount, dev);
        (void)hipFuncSetAttribute((const void*)yoco_fwd, hipFuncAttributeMaxDynamicSharedMemorySize, LDS_BYTES);
        (void)hipOccupancyMaxActiveBlocksPerMultiprocessor(&per_cu, (const void*)yoco_fwd, NTHR, LDS_BYTES);
        if (per_cu < 1) per_cu = 1;
        grid = cus * per_cu;
        (void)hipGetLastError();
    }
    if (grid < 0) return;
    Args a{};
    for (int i = 0; i < 13; ++i) a.in[i] = (const float*)d_in[i];
    a.out = (float*)d_out; a.ws = (unsigned char*)d_ws; a.ph_lo = 0; a.ph_hi = 12;
    (void)hipMemsetAsync((char*)d_ws + WS_BAR, 0, BAR_BYTES, stream);
    void* args[] = {&a};
    hipError_t e = hipLaunchCooperativeKernel((const void*)yoco_fwd, dim3(grid), dim3(NTHR), args, LDS_BYTES, stream);
    if (e != hipSuccess) fprintf(stderr, "cooperative launch failed: %s (grid %d)\n", hipGetErrorString(e), grid);
}
```
